# Optimizing an MI355X kernel written in HIP

```python
import math
import jax, jax.numpy as jnp
from jax import lax
import numpy as np

D_MODEL = 1024
BATCH = 32
SEQ = 256
DEPTH = 1
DEC_BATCH = 2
DEC_SEQ = 1024
PAST_LEN = 512

GRID_W = 64
MIX_WIDTH = D_MODEL
ATTN_WIDTH = MIX_WIDTH // 2
CONV_WIDTH = MIX_WIDTH - ATTN_WIDTH
N_HEADS = 4
HEAD_DIM = ATTN_WIDTH // (2 * N_HEADS)
V_DIM = 2 * HEAD_DIM
CONV_K = 3
D_FF = 2816
ROPE_BASE = 10000.0
EPS = 1e-6
Q_BLOCK = 128
N_SUB = 3
IN_WIDTH = 3 * ATTN_WIDTH + 3 * CONV_WIDTH

kernel_name = "hybrid_diffattn_shortconv_prefix_dit_step"


def rmsnorm(x, g):
    xf = x.astype(jnp.float32)
    y = xf * lax.rsqrt(jnp.mean(xf * xf, axis=-1, keepdims=True) + EPS)
    return (y * g.astype(jnp.float32)).astype(x.dtype)


def modulation(cond, w_mod, b_mod):
    m = jax.nn.silu(cond) @ w_mod + b_mod
    return m.reshape(cond.shape[0], N_SUB, 3, D_MODEL)


def swiglu(u, w_up, w_down):
    a, b = jnp.split(u @ w_up, 2, axis=-1)
    return (jax.nn.silu(a) * b) @ w_down


def short_conv(u, w):
    T = u.shape[1]
    up = jnp.pad(u, ((0, 0), (1, 1), (0, 0)))
    return up[:, :T] * w[0] + up[:, 1:T + 1] * w[1] + up[:, 2:] * w[2]


def _rot_half(x, cos, sin):
    x1, x2 = jnp.split(x, 2, axis=-1)
    return jnp.concatenate([x1 * cos - x2 * sin, x2 * cos + x1 * sin], axis=-1)


def axial_rope(x):
    T = x.shape[1]
    rows = T // GRID_W
    row = jnp.repeat(jnp.arange(rows, dtype=jnp.float32), GRID_W)
    col = jnp.tile(jnp.arange(GRID_W, dtype=jnp.float32), rows)
    half = HEAD_DIM // 2
    freqs = ROPE_BASE ** (-jnp.arange(0, half, 2, dtype=jnp.float32) / half)
    ang_r = (row[:, None] * freqs)[None, :, None, None, :]
    ang_c = (col[:, None] * freqs)[None, :, None, None, :]
    dt = x.dtype
    xr = _rot_half(x[..., :half], jnp.cos(ang_r).astype(dt), jnp.sin(ang_r).astype(dt))
    xc = _rot_half(x[..., half:], jnp.cos(ang_c).astype(dt), jnp.sin(ang_c).astype(dt))
    return jnp.concatenate([xr, xc], axis=-1)


def diff_attention(q, k, v, lam):
    B, Tq = q.shape[0], q.shape[1]
    qb = math.gcd(Q_BLOCK, Tq)
    nb = Tq // qb
    scale = HEAD_DIM ** -0.5

    def block(qblk):
        s = jnp.einsum('bqhid,bkhid->bhiqk', qblk, k).astype(jnp.float32) * scale
        p = jax.nn.softmax(s, axis=-1)
        pd = (p[:, :, 0] - lam * p[:, :, 1]).astype(v.dtype)
        return jnp.einsum('bhqk,bkhe->bqhe', pd, v)

    qs = q.reshape(B, nb, qb, N_HEADS, 2, HEAD_DIM).swapaxes(0, 1)
    o = lax.map(block, qs)
    return o.swapaxes(0, 1).reshape(B, Tq, N_HEADS, V_DIM)


def mixer(u, w_in, conv_w, lam_qk, subln_g, w_o, lambda_init, ctx_k, ctx_v):
    N, T, _ = u.shape
    A, C = ATTN_WIDTH, CONV_WIDTH
    proj = u @ w_in
    q, k, v, bg, cg, xc = jnp.split(proj, [A, 2 * A, 3 * A, 3 * A + C, 3 * A + 2 * C], axis=-1)
    q = q.reshape(N, T, N_HEADS, 2, HEAD_DIM)
    k = k.reshape(N, T, N_HEADS, 2, HEAD_DIM)
    v = v.reshape(N, T, N_HEADS, V_DIM)
    lq = lam_qk.astype(jnp.float32)
    lam = jnp.exp(jnp.sum(lq[0] * lq[1])) - jnp.exp(jnp.sum(lq[2] * lq[3])) + lambda_init
    if ctx_k is None:
        k_all, v_all = k, v
    else:
        q = axial_rope(q)
        k_lat = axial_rope(k)
        L = ctx_k.shape[1]
        k_all = jnp.concatenate([ctx_k.reshape(N, L, N_HEADS, 2, HEAD_DIM), k_lat], axis=1)
        v_all = jnp.concatenate([ctx_v, v], axis=1)
    o = diff_attention(q, k_all, v_all, lam)
    o = rmsnorm(o, subln_g) * (1.0 - lambda_init)
    conv_out = bg * short_conv(cg * xc, conv_w)
    out = jnp.concatenate([o.reshape(N, T, A), conv_out], axis=-1) @ w_o
    return out, k.reshape(N, T, N_HEADS, 2 * HEAD_DIM), v


def trunk_layer(x, mod, ln_pre, ln_post, f1u, f1d, f2u, f2d, w_in, conv_w, lam_qk, subln_g, w_o,
                lambda_init, ctx_k, ctx_v):
    def smg(i):
        return mod[:, i, 0, None, :], mod[:, i, 1, None, :], mod[:, i, 2, None, :]

    sh, sc, gt = smg(0)
    u = rmsnorm(x, ln_pre[0]) * (1.0 + sc) + sh
    x = x + 0.5 * gt * rmsnorm(swiglu(u, f1u, f1d), ln_post[0])

    sh, sc, gt = smg(1)
    u = rmsnorm(x, ln_pre[1]) * (1.0 + sc) + sh
    mix_out, k, v = mixer(u, w_in, conv_w, lam_qk, subln_g, w_o, lambda_init, ctx_k, ctx_v)
    x = x + gt * rmsnorm(mix_out, ln_post[1])

    sh, sc, gt = smg(2)
    u = rmsnorm(x, ln_pre[2]) * (1.0 + sc) + sh
    x = x + 0.5 * gt * rmsnorm(swiglu(u, f2u, f2d), ln_post[2])
    return x, k, v


def setup_inputs(seed: int = 0) -> dict:
    key = jax.random.key(seed)
    ks = jax.random.split(key, 20)
    f32 = jnp.float32

    def nrm(k, shape, s):
        return jax.random.normal(k, shape, f32) * s

    return {
        "x_prompt": nrm(ks[0], (BATCH, SEQ, D_MODEL), 1.0),
        "x_sample": nrm(ks[1], (DEC_BATCH, DEC_SEQ, D_MODEL), 1.0),
        "c": nrm(ks[2], (DEC_BATCH, D_MODEL), 1.0),
        "cache_k": nrm(ks[3], (DEC_BATCH, DEPTH, PAST_LEN, N_HEADS, 2 * HEAD_DIM), 1.0),
        "cache_v": nrm(ks[4], (DEC_BATCH, DEPTH, PAST_LEN, N_HEADS, V_DIM), 1.0),
        "c_ctx": nrm(ks[5], (D_MODEL,), 1.0),
        "w_mod": nrm(ks[6], (DEPTH, D_MODEL, N_SUB * 3 * D_MODEL), 0.5 * D_MODEL ** -0.5),
        "b_mod": nrm(ks[7], (DEPTH, N_SUB * 3 * D_MODEL), 0.02),
        "norm_pre": 1.0 + nrm(ks[8], (DEPTH, N_SUB, D_MODEL), 0.02),
        "norm_post": 1.0 + nrm(ks[9], (DEPTH, N_SUB, D_MODEL), 0.02),
        "ffn1_up": nrm(ks[10], (DEPTH, D_MODEL, 2 * D_FF), D_MODEL ** -0.5),
        "ffn1_down": nrm(ks[11], (DEPTH, D_FF, D_MODEL), D_FF ** -0.5),
        "ffn2_up": nrm(ks[12], (DEPTH, D_MODEL, 2 * D_FF), D_MODEL ** -0.5),
        "ffn2_down": nrm(ks[13], (DEPTH, D_FF, D_MODEL), D_FF ** -0.5),
        "w_in": nrm(ks[14], (DEPTH, D_MODEL, IN_WIDTH), D_MODEL ** -0.5),
        "conv_w": nrm(ks[15], (DEPTH, CONV_K, CONV_WIDTH), CONV_K ** -0.5),
        "lam_qk": nrm(ks[16], (DEPTH, 4, HEAD_DIM), 0.1),
        "subln_g": 1.0 + nrm(ks[17], (DEPTH, V_DIM), 0.02),
        "w_o": nrm(ks[18], (DEPTH, MIX_WIDTH, D_MODEL), MIX_WIDTH ** -0.5),
    }


def reference(x_prompt, x_sample, c, cache_k, cache_v, c_ctx, w_mod, b_mod, norm_pre, norm_post,
              ffn1_up, ffn1_down, ffn2_up, ffn2_down, w_in, conv_w, lam_qk, subln_g, w_o):
    h = x_prompt
    new_k, new_v = [], []
    for l in range(DEPTH):
        lambda_init = 0.8 - 0.6 * math.exp(-0.3 * l)
        mod = modulation(c_ctx[None, :], w_mod[l], b_mod[l])
        h, k_l, v_l = trunk_layer(h, mod, norm_pre[l], norm_post[l], ffn1_up[l], ffn1_down[l],
                                  ffn2_up[l], ffn2_down[l], w_in[l], conv_w[l], lam_qk[l],
                                  subln_g[l], w_o[l], lambda_init, None, None)
        new_k.append(k_l)
        new_v.append(v_l)
    y_prompt = h

    h = x_sample
    for l in range(DEPTH):
        lambda_init = 0.8 - 0.6 * math.exp(-0.3 * l)
        mod = modulation(c, w_mod[l], b_mod[l])
        h, _, _ = trunk_layer(h, mod, norm_pre[l], norm_post[l], ffn1_up[l], ffn1_down[l],
                              ffn2_up[l], ffn2_down[l], w_in[l], conv_w[l], lam_qk[l],
                              subln_g[l], w_o[l], lambda_init, cache_k[:, l], cache_v[:, l])
    y_sample = h
    return (y_prompt, y_sample, jnp.stack(new_k, axis=1), jnp.stack(new_v, axis=1))
```

```cpp
#include <hip/hip_runtime.h>
#include <hip/hip_cooperative_groups.h>
#include <cstdio>
#include <cstdint>
#ifndef MK_N_LAUNCHES
#define MK_N_LAUNCHES 1
#endif
namespace pg8 {
#define PG8_LAS __attribute__((address_space(3)))
typedef unsigned short bf16_t;
typedef short bf16x8 __attribute__((ext_vector_type(8)));
typedef float f32x4 __attribute__((ext_vector_type(4)));
typedef unsigned u32x4 __attribute__((ext_vector_type(4)));
constexpr int BM = 256, BK = 64, HALF = 128, HTB = HALF * BK * 2  , STAGE_BYTES = 8 * HTB, NXCD = 8, WGM = 8;

__host__ __device__ __forceinline__ int lds_byte(int r, int c) { const int st = (r >> 4) * 2 + (c >> 5), rr = r & 15, cc = c & 31, ob = rr * 64 + cc * 2; return st * 1024 + (ob ^ (((ob >> 9) & 1) << 5)); }
__host__ __device__ __forceinline__ void stage_rc(int b, int& R, int& C) { const int st = b / 1024, sb = b % 1024, swz = sb ^ (((sb >> 9) & 1) << 5); R = (st >> 1) * 16 + swz / 64; C = (st & 1) * 32 + (swz % 64) / 2; }
__host__ __device__ __forceinline__ int perm32(int rho) { const int n = rho >> 4, i = rho & 15; return 8 * (i >> 2) + 4 * n + (i & 3); }

struct Unit { int pm, pn, half; };
struct Gemm { const bf16_t* A; const bf16_t* Bt; int M, N, K; };

struct StaticOrder {
    int nM, nN, nwg, G, c;
    __host__ __device__ void init(int M, int N, int G_, int c_) { nM = M / BM; nN = N / BM; nwg = nM * nN; G = G_; c = c_; }
    __host__ __device__ bool next(int i, Unit& u) const {
        const long L = (long)i * G + c; if (L >= nwg) return false;
        int wgid = (int)L; { const int q = nwg / NXCD, r = nwg % NXCD, xcd = wgid % NXCD, off = wgid / NXCD; wgid = (xcd < r ? xcd * (q + 1) : r * (q + 1) + (xcd - r) * q) + off; }
        const int nig = WGM * nN, gid = wgid / nig, fm = gid * WGM, gsz = (nM - fm) < WGM ? (nM - fm) : WGM;
        u.pm = fm + ((wgid % nig) % gsz); u.pn = (wgid % nig) / gsz; u.half = 0; return true;
    }
    __device__ __forceinline__ void a_ready(const Unit&) const {}
    __device__ __forceinline__ void done(const Unit&) const {}
};
struct TailSplitOrder {
    int nM, nN, nwg, G, c, nfull, nitems;
    __host__ __device__ void init(int M, int N, int G_, int c_) { nM = M / BM; nN = N / BM; nwg = nM * nN; G = G_; c = c_; nfull = (nwg / G) * G; const int rem = nwg - nfull;
        if (2 * rem > G) { nfull = nwg; } nitems = nfull + 2 * (nwg - nfull); }
    __host__ __device__ bool next(int i, Unit& u) const {
        const long L = (long)i * G + c; if (L >= nitems) return false;
        int wgid, half; if (L < nfull) { wgid = (int)L; half = 0; } else { wgid = nfull + (int)(L - nfull) / 2; half = 1 + (int)((L - nfull) & 1); }
        { const int q = nwg / NXCD, r = nwg % NXCD, xcd = wgid % NXCD, off = wgid / NXCD; wgid = (xcd < r ? xcd * (q + 1) : r * (q + 1) + (xcd - r) * q) + off; }
        const int nig = WGM * nN, gid = wgid / nig, fm = gid * WGM, gsz = (nM - fm) < WGM ? (nM - fm) : WGM;
        u.pm = fm + ((wgid % nig) % gsz); u.pn = (wgid % nig) / gsz; u.half = half; return true;
    }
    __device__ __forceinline__ void a_ready(const Unit&) const {}
    __device__ __forceinline__ void done(const Unit&) const {}
};
typedef float f32x2c __attribute__((ext_vector_type(2))); typedef __bf16 bf16x2c __attribute__((ext_vector_type(2)));
__device__ __forceinline__ unsigned cvt_pk_bf16(float lo, float hi) { const f32x2c v = {lo, hi}; const bf16x2c b = __builtin_convertvector(v, bf16x2c); return __builtin_bit_cast(unsigned, b); }
typedef float f32x2 __attribute__((ext_vector_type(2)));
typedef unsigned u32x2 __attribute__((ext_vector_type(2)));
__device__ __forceinline__ f32x4 silu_mul(f32x4 a, f32x4 b) {
    f32x4 o;
#pragma unroll
    for (int j = 0; j < 4; ++j) { const float e = __builtin_amdgcn_exp2f(a[j] * -1.4426950408889634f); o[j] = a[j] * b[j] * __builtin_amdgcn_rcpf(1.0f + e); }
    return o;
}
struct EpiSwiGLU {
    static constexpr bool PERM = false, AFTER_DRAIN = false;
    bf16_t* G; int ldg;
    __device__ __forceinline__ void operator()(const f32x4 (&acc)[2][2][4][2], const Unit& u, int wr, int wc, int fr, int fq) const {
        const int row0 = u.pm * BM + wr * 64 + fr, col0 = u.pn * HALF + wc * 32 + 8 * fq;
#pragma unroll
        for (int ai = 0; ai < 2; ++ai) { if (u.half && u.half != ai + 1) continue;
#pragma unroll
            for (int m = 0; m < 4; ++m) {
                const f32x4 g0 = silu_mul(acc[ai][0][m][0], acc[ai][1][m][0]), g1 = silu_mul(acc[ai][0][m][1], acc[ai][1][m][1]);
                u32x4 w; w.x = cvt_pk_bf16(g0[0], g0[1]); w.y = cvt_pk_bf16(g0[2], g0[3]); w.z = cvt_pk_bf16(g1[0], g1[1]); w.w = cvt_pk_bf16(g1[2], g1[3]);
                *(u32x4*)(G + (size_t)(row0 + ai * HALF + m * 16) * ldg + col0) = w; } }
    }
};
struct EpiY {
    static constexpr bool PERM = false, AFTER_DRAIN = false;
    bf16_t* C; int ldc;
    __device__ __forceinline__ void operator()(const f32x4 (&acc)[2][2][4][2], const Unit& u, int wr, int wc, int fr, int fq) const {
        const int row0 = u.pm * BM + wr * 64 + fr, col0 = u.pn * BM + wc * 32 + 8 * fq;
#pragma unroll
        for (int ai = 0; ai < 2; ++ai)
#pragma unroll
            for (int m = 0; m < 4; ++m) { bf16_t* rowp = C + (size_t)(row0 + ai * HALF + m * 16) * ldc + col0;
#pragma unroll
                for (int bj = 0; bj < 2; ++bj) { const f32x4 v0 = acc[ai][bj][m][0], v1 = acc[ai][bj][m][1];
                    u32x4 w; w.x = cvt_pk_bf16(v0[0], v0[1]); w.y = cvt_pk_bf16(v0[2], v0[3]); w.z = cvt_pk_bf16(v1[0], v1[1]); w.w = cvt_pk_bf16(v1[2], v1[3]); *(u32x4*)(rowp + bj * HALF) = w; } }
    }
};
struct EpiMix {
    static constexpr bool PERM = false, AFTER_DRAIN = false;
    bf16_t *Qb, *Kctx, *Klat, *Vtctx, *Vtlat, *BGb, *Zb; float *newk, *newv; const float *ropeC, *ropeS;
    __device__ __forceinline__ void operator()(const f32x4 (&acc)[2][2][4][2], const Unit& u, int wr, int wc, int fr, int fq) const {
        const int pn = u.pn, pm = u.pm; const bool lat = pm >= 32;
        const int lb = (pm - 32) >> 2, lt0 = ((pm - 32) & 3) * 256;
        const float C2 = 0.125f * 1.4426950408889634f;
        if (pn < 4) {
            const bool isk = pn >= 2; const int colbase = (pn & 1) * 256 + wc * 32 + 4 * fq;
#pragma unroll
            for (int ai = 0; ai < 2; ++ai)
#pragma unroll
                for (int m = 0; m < 4; ++m) {
                    const int rl = wr * 64 + fr + ai * HALF + m * 16, R = pm * BM + rl, t = lt0 + rl;
                    f32x4 c4 = {1.f, 1.f, 1.f, 1.f}, s4 = {0.f, 0.f, 0.f, 0.f};
                    if (lat) { const int pos = (wc & 1) ? (t & 63) : (t >> 6); c4 = *(const f32x4*)(ropeC + pos * 16 + 4 * fq); s4 = *(const f32x4*)(ropeS + pos * 16 + 4 * fq); }
                    bf16_t* dst = !isk ? Qb + (size_t)R * 512 : (lat ? Klat + (size_t)(lb * 1536 + 512 + t) * 512 : Kctx + (size_t)R * 512);
#pragma unroll
                    for (int bj = 0; bj < 2; ++bj) {
                        f32x4 x1 = acc[ai][bj][m][0], x2 = acc[ai][bj][m][1];
                        const int col = colbase + bj * HALF;
                        if (isk && !lat) { *(f32x4*)(newk + (size_t)R * 512 + col) = x1; *(f32x4*)(newk + (size_t)R * 512 + col + 16) = x2; }
                        const f32x4 y1 = x1 * c4 - x2 * s4, y2 = x2 * c4 + x1 * s4; x1 = y1; x2 = y2;
                        if (!isk) { x1 = x1 * C2; x2 = x2 * C2; }
                        u32x4 w; w.x = cvt_pk_bf16(x1[0], x1[1]); w.y = cvt_pk_bf16(x1[2], x1[3]); w.z = cvt_pk_bf16(x2[0], x2[1]); w.w = cvt_pk_bf16(x2[2], x2[3]);
                        *(u32x4*)(dst + (pn & 1) * 256 + bj * HALF + wc * 32 + 8 * fq) = w; } }
        } else if (pn < 6) {
            const int colbase = (pn - 4) * 256 + wc * 32 + 4 * fq;
#pragma unroll
            for (int ai = 0; ai < 2; ++ai)
#pragma unroll
                for (int m = 0; m < 4; ++m) {
                    const int rl = wr * 64 + fr + ai * HALF + m * 16, R = pm * BM + rl, t = lt0 + rl;
                    bf16_t* vt = lat ? Vtlat + (size_t)(lb * 512) * 1536 + 512 + t : Vtctx + (size_t)(pm * 512) * 256 + rl;
                    const size_t ldv = lat ? 1536 : 256;
#pragma unroll
                    for (int bj = 0; bj < 2; ++bj)
#pragma unroll
                        for (int n = 0; n < 2; ++n) { const f32x4 v = acc[ai][bj][m][n]; const int col = colbase + bj * HALF + n * 16;
                            if (!lat) *(f32x4*)(newv + (size_t)R * 512 + col) = v;
                            const unsigned p01 = cvt_pk_bf16(v[0], v[1]), p23 = cvt_pk_bf16(v[2], v[3]);
                            vt[(size_t)(col + 0) * ldv] = (bf16_t)(p01 & 0xffffu); vt[(size_t)(col + 1) * ldv] = (bf16_t)(p01 >> 16);
                            vt[(size_t)(col + 2) * ldv] = (bf16_t)(p23 & 0xffffu); vt[(size_t)(col + 3) * ldv] = (bf16_t)(p23 >> 16); } }
        } else if (pn < 8) {
            const int colbase = (pn - 6) * 256 + wc * 32 + 8 * fq;
#pragma unroll
            for (int ai = 0; ai < 2; ++ai)
#pragma unroll
                for (int m = 0; m < 4; ++m) { bf16_t* dst = BGb + (size_t)(pm * BM + wr * 64 + fr + ai * HALF + m * 16) * 512 + colbase;
#pragma unroll
                    for (int bj = 0; bj < 2; ++bj) { const f32x4 v0 = acc[ai][bj][m][0], v1 = acc[ai][bj][m][1];
                        u32x4 w; w.x = cvt_pk_bf16(v0[0], v0[1]); w.y = cvt_pk_bf16(v0[2], v0[3]); w.z = cvt_pk_bf16(v1[0], v1[1]); w.w = cvt_pk_bf16(v1[2], v1[3]); *(u32x4*)(dst + bj * HALF) = w; } }
        } else {
            const int col0 = (pn - 8) * HALF + wc * 32 + 8 * fq;
#pragma unroll
            for (int ai = 0; ai < 2; ++ai)
#pragma unroll
                for (int m = 0; m < 4; ++m) { const f32x4 z0 = acc[ai][0][m][0] * acc[ai][1][m][0], z1 = acc[ai][0][m][1] * acc[ai][1][m][1];
                    u32x4 w; w.x = cvt_pk_bf16(z0[0], z0[1]); w.y = cvt_pk_bf16(z0[2], z0[3]); w.z = cvt_pk_bf16(z1[0], z1[1]); w.w = cvt_pk_bf16(z1[2], z1[3]);
                    *(u32x4*)(Zb + (size_t)(pm * BM + wr * 64 + fr + ai * HALF + m * 16) * 512 + col0) = w; }
        }
    }
};
template <class Epi, class Sched, bool ALIGN_EPI = false, bool SP2 = false, bool HALFABLE = false>
__device__ __forceinline__ void gemm_phase(PG8_LAS unsigned char* lds, const Gemm g, const Sched& S, const Epi& E) {
    const int tid = threadIdx.x, wid = __builtin_amdgcn_readfirstlane(tid >> 6), lane = tid & 63, wr = wid >> 2, wc = wid & 3, fr = lane & 15, fq = lane >> 4;
    const int K = g.K, nt = K / BK;
    unsigned voffA[2], voffB[2];
#pragma unroll
    for (int i = 0; i < 2; ++i) { int R, C; stage_rc(tid * 16 + i * 8192, R, C); const int Rb = Epi::PERM ? ((R & ~31) + perm32(R & 31)) : R;
        voffA[i] = (unsigned)(R * K + C) * 2u; voffB[i] = (unsigned)(Rb * K + C) * 2u; }
    const size_t kstep = (size_t)(BK * 2);
    const size_t hstep = (size_t)HALF * K * 2;
    const size_t tstep = 2 * hstep;
    const unsigned ldsw = (unsigned)wid * 1024u;
    const int aoff = lds_byte(wr * 64 + fr, fq * 8), boff = lds_byte(wc * 32 + fr, fq * 8);
#define PG8_SA(b, h) (((b) * 2 + (h)) * HTB)
#define PG8_SB(b, h) ((4 + (b) * 2 + (h)) * HTB)
#define PG8_STAGE(bufoff, gbase, voff) do { _Pragma("unroll") for (int _i = 0; _i < 2; ++_i) \
        __builtin_amdgcn_global_load_lds((const unsigned*)((const char*)(gbase) + (voff)[_i]), (PG8_LAS unsigned*)(lds + (bufoff) + ldsw + _i * 8192), 16, 0, 0); } while (0)
#define PG8_LDA(dst, b, h) do { _Pragma("unroll") for (int m = 0; m < 4; ++m) _Pragma("unroll") for (int k = 0; k < 2; ++k) dst[m][k] = *(const PG8_LAS bf16x8*)(lds + PG8_SA(b, h) + aoff + m * 2048 + k * 1024); } while (0)
#define PG8_LDB(dst, b, h) do { _Pragma("unroll") for (int n = 0; n < 2; ++n) _Pragma("unroll") for (int k = 0; k < 2; ++k) dst[n][k] = *(const PG8_LAS bf16x8*)(lds + PG8_SB(b, h) + boff + n * 2048 + k * 1024); } while (0)
#define PG8_MMA(ai, bj, At, Bt) do { __builtin_amdgcn_s_setprio(1); _Pragma("unroll") for (int m = 0; m < 4; ++m) _Pragma("unroll") for (int n = 0; n < 2; ++n) _Pragma("unroll") for (int k = 0; k < 2; ++k) \
        acc[ai][bj][m][n] = __builtin_amdgcn_mfma_f32_16x16x32_bf16(Bt[n][k], At[m][k], acc[ai][bj][m][n], 0, 0, 0); __builtin_amdgcn_s_setprio(0); } while (0)
#define PG8_WAIT_V(n) asm volatile("s_waitcnt vmcnt(" #n ")" ::: "memory")
#define PG8_WAIT_L(n) asm volatile("s_waitcnt lgkmcnt(" #n ")" ::: "memory")
#define PG8_BAR __builtin_amdgcn_s_barrier()
#define PG8_SCHED __builtin_amdgcn_sched_barrier(0)
    Unit cur, nxt; int ui = 0;
    if (!S.next(0, cur)) return;
    f32x4 acc[2][2][4][2];
#pragma unroll
    for (int a = 0; a < 2; ++a)
#pragma unroll
        for (int b = 0; b < 2; ++b)
#pragma unroll
            for (int m = 0; m < 4; ++m)
#pragma unroll
                for (int n = 0; n < 2; ++n) acc[a][b][m][n] = (f32x4){0.f, 0.f, 0.f, 0.f};
    bf16x8 At[4][2], B0[2][2], B1[2][2];
    const char* cA = (const char*)g.A + (size_t)cur.pm * tstep; const char* cB = (const char*)g.Bt + (size_t)cur.pn * tstep;
    S.a_ready(cur);
    if constexpr (SP2) {
        PG8_STAGE(PG8_SB(0, 0), cB, voffB); PG8_STAGE(PG8_SB(0, 1), cB + hstep, voffB); PG8_STAGE(PG8_SA(0, 0), cA, voffA); PG8_STAGE(PG8_SA(0, 1), cA + hstep, voffA);
        if (wr == 1) PG8_BAR;
        PG8_WAIT_V(2); PG8_BAR;
        PG8_STAGE(PG8_SB(1, 0), cB + kstep, voffB); PG8_STAGE(PG8_SA(1, 0), cA + kstep, voffA); PG8_STAGE(PG8_SB(1, 1), cB + hstep + kstep, voffB);
        PG8_WAIT_V(6); PG8_BAR;
    } else {
        PG8_STAGE(PG8_SB(0, 0), cB, voffB); PG8_STAGE(PG8_SA(0, 0), cA, voffA); PG8_STAGE(PG8_SB(0, 1), cB + hstep, voffB); PG8_STAGE(PG8_SA(0, 1), cA + hstep, voffA);
        if (wr == 1) PG8_BAR;
        PG8_WAIT_V(4); PG8_BAR;
        PG8_STAGE(PG8_SB(1, 0), cB + kstep, voffB); PG8_STAGE(PG8_SA(1, 0), cA + kstep, voffA); PG8_STAGE(PG8_SB(1, 1), cB + hstep + kstep, voffB);
        PG8_WAIT_V(6); PG8_BAR;
    }
    for (;;) {
        const bool has_next = S.next(ui + 1, nxt);
        const bool do0 = !HALFABLE || cur.half != 2, do1 = !HALFABLE || cur.half != 1;
        const char* nA = has_next ? (const char*)g.A + (size_t)nxt.pm * tstep : cA; const char* nB = has_next ? (const char*)g.Bt + (size_t)nxt.pn * tstep : cB;
        for (int t = 0; t < nt; t += 2) {
            const bool last = (t == nt - 2);
            const char* a1 = cA + (size_t)(t + 1) * kstep;
            const char* a2 = last ? nA : cA + (size_t)(t + 2) * kstep; const char* b2 = last ? nB : cB + (size_t)(t + 2) * kstep;
            const char* a3 = a2 + kstep; const char* b3 = b2 + kstep;
            if (last && has_next) S.a_ready(nxt);
            if constexpr (SP2) {
            PG8_LDB(B0, 0, 0); PG8_LDB(B1, 0, 1); PG8_SCHED; if (do0) PG8_LDA(At, 0, 0); PG8_STAGE(PG8_SA(1, 1), a1 + hstep, voffA);
            PG8_WAIT_V(8); PG8_WAIT_L(0); PG8_BAR; if (do0) { PG8_MMA(0, 0, At, B0); PG8_MMA(0, 1, At, B1); } PG8_BAR; PG8_SCHED;
            if (do1) PG8_LDA(At, 0, 1); PG8_STAGE(PG8_SB(0, 0), b2, voffB); PG8_STAGE(PG8_SB(0, 1), b2 + hstep, voffB); PG8_STAGE(PG8_SA(0, 0), a2, voffA);
            PG8_WAIT_V(8); PG8_WAIT_L(0); PG8_BAR; if (do1) { PG8_MMA(1, 0, At, B0); PG8_MMA(1, 1, At, B1); } PG8_BAR; PG8_SCHED;
            PG8_LDB(B0, 1, 0); PG8_LDB(B1, 1, 1); PG8_SCHED; if (do0) PG8_LDA(At, 1, 0); PG8_STAGE(PG8_SA(0, 1), a2 + hstep, voffA);
            PG8_WAIT_V(8); PG8_WAIT_L(0); PG8_BAR; if (do0) { PG8_MMA(0, 0, At, B0); PG8_MMA(0, 1, At, B1); } PG8_BAR; PG8_SCHED;
            if (do1) PG8_LDA(At, 1, 1); PG8_STAGE(PG8_SB(1, 0), b3, voffB); PG8_STAGE(PG8_SB(1, 1), b3 + hstep, voffB); PG8_STAGE(PG8_SA(1, 0), a3, voffA);
            PG8_WAIT_V(8); PG8_WAIT_L(0); PG8_BAR; if (do1) { PG8_MMA(1, 0, At, B0); PG8_MMA(1, 1, At, B1); } PG8_BAR; PG8_SCHED;
            } else {
            PG8_LDB(B0, 0, 0); PG8_SCHED; PG8_LDA(At, 0, 0); PG8_STAGE(PG8_SA(1, 1), a1 + hstep, voffA);
            PG8_WAIT_L(8); PG8_BAR; PG8_WAIT_L(0); PG8_MMA(0, 0, At, B0); PG8_BAR; PG8_SCHED;
            PG8_LDB(B1, 0, 1); PG8_STAGE(PG8_SB(0, 0), b2, voffB);
            PG8_BAR; PG8_WAIT_L(0); PG8_MMA(0, 1, At, B1); PG8_BAR;
            PG8_LDA(At, 0, 1); PG8_STAGE(PG8_SA(0, 0), a2, voffA);
            PG8_BAR; PG8_WAIT_L(0); PG8_MMA(1, 0, At, B0); PG8_BAR; PG8_SCHED;
            PG8_STAGE(PG8_SB(0, 1), b2 + hstep, voffB);
            PG8_WAIT_V(6); PG8_BAR; PG8_MMA(1, 1, At, B1); PG8_BAR;
            PG8_LDB(B0, 1, 0); PG8_SCHED; PG8_LDA(At, 1, 0); PG8_STAGE(PG8_SA(0, 1), a2 + hstep, voffA);
            PG8_WAIT_L(8); PG8_BAR; PG8_WAIT_L(0); PG8_MMA(0, 0, At, B0); PG8_BAR; PG8_SCHED;
            PG8_LDB(B1, 1, 1); PG8_STAGE(PG8_SB(1, 0), b3, voffB);
            PG8_BAR; PG8_WAIT_L(0); PG8_MMA(0, 1, At, B1); PG8_BAR;
            PG8_LDA(At, 1, 1); PG8_STAGE(PG8_SA(1, 0), a3, voffA);
            PG8_BAR; PG8_WAIT_L(0); PG8_MMA(1, 0, At, B0); PG8_BAR; PG8_SCHED;
            PG8_STAGE(PG8_SB(1, 1), b3 + hstep, voffB);
            PG8_WAIT_V(6); PG8_BAR; PG8_MMA(1, 1, At, B1); PG8_BAR;
            }
        }
        if constexpr (ALIGN_EPI) { if (wr == 0) PG8_BAR; }
        if constexpr (!Epi::AFTER_DRAIN) { E(acc, cur, wr, wc, fr, fq); S.done(cur); }
        if (!has_next) break;
#pragma unroll
        for (int a = 0; a < 2; ++a)
#pragma unroll
            for (int b = 0; b < 2; ++b)
#pragma unroll
                for (int m = 0; m < 4; ++m)
#pragma unroll
                    for (int n = 0; n < 2; ++n) acc[a][b][m][n] = (f32x4){0.f, 0.f, 0.f, 0.f};
        cur = nxt; cA = nA; cB = nB; ++ui;
        if constexpr (ALIGN_EPI) { if (wr == 1) PG8_BAR; }
    }
    PG8_WAIT_V(0);
    if constexpr (!ALIGN_EPI) { if (wr == 0) PG8_BAR; }
    PG8_BAR;
    if constexpr (Epi::AFTER_DRAIN) { E.fused(acc, cur, wr, wc, fr, fq, lds, wid, lane); S.done(cur); }
#undef PG8_SA
#undef PG8_SB
#undef PG8_STAGE
#undef PG8_LDA
#undef PG8_LDB
#undef PG8_MMA
#undef PG8_WAIT_V
#undef PG8_WAIT_L
#undef PG8_BAR
#undef PG8_SCHED
}
}
constexpr int NWAVES = 8;
constexpr int D = 1024, MC = 8192, MLAT = 2048, M = MC + MLAT, FF = 2816, NUP = 2 * FF, NIN = 3072, AW = 512;
constexpr int TC = 256, TL = 1024, PAST = 512, TKL = PAST + TL, NMODC = 9 * D;
constexpr float EPS = 1e-6f;
constexpr size_t OUT_Y = 0, OUT_NK = (size_t)M * D, OUT_NV = OUT_NK + (size_t)MC * AW;
constexpr size_t MiB = 1u << 20, HMiB = 1u << 19;
constexpr size_t WS_CTL = 0, CTL_ZERO_BYTES = 64 * 1024;
constexpr size_t WS_MISC = 1 * MiB;
constexpr size_t WS_W1U = 2 * MiB, WS_W1D = 13 * MiB, WS_W2U = 13 * MiB + 11 * HMiB, WS_W2D = WS_W2U + 11 * MiB, WS_WIN = 35 * MiB, WS_WO = 41 * MiB;
constexpr size_t WS_KLAT = 43 * MiB, WS_VTLAT = 46 * MiB, WS_U = 49 * MiB, WS_Y = 69 * MiB, WS_X1 = 109 * MiB, WS_R = 149 * MiB;
constexpr size_t WS_G = WS_R, WS_QB = WS_R, WS_KCTX = WS_R + 10 * MiB, WS_VTCTX = WS_R + 18 * MiB, WS_BG = WS_R + 26 * MiB, WS_Z = WS_R + 36 * MiB, WS_MIX = WS_R + 46 * MiB;
constexpr size_t WS_END = WS_R + 66 * MiB;
static_assert(WS_W2D + 11 * HMiB == WS_WIN && WS_G + (size_t)M * FF * 2 <= WS_END && WS_END <= 256 * MiB, "ws map");
constexpr int CW_BAR = 1024;
constexpr int RING_BYTES = 131072, LDSCTL_OFF = RING_BYTES, MISC_OFF = LDSCTL_OFF + 320, LDS_BYTES = 147456;

#define GAS __attribute__((address_space(1)))
#define LAS __attribute__((address_space(3)))
typedef unsigned short bf16;
typedef unsigned v4u __attribute__((ext_vector_type(4)));
typedef unsigned v2u __attribute__((ext_vector_type(2)));
typedef float f32x4 __attribute__((ext_vector_type(4)));
typedef float f32x16 __attribute__((ext_vector_type(16)));
typedef short bf16x8 __attribute__((ext_vector_type(8)));
typedef short s16x4 __attribute__((ext_vector_type(4)));
#define LDS_WAIT() asm volatile("s_waitcnt lgkmcnt(0)" ::: "memory")
__device__ __forceinline__ unsigned f2bf(float f) { unsigned u = __builtin_bit_cast(unsigned, f); return (u + 0x7fffu + ((u >> 16) & 1u)) >> 16; }
typedef float f32x2_t __attribute__((ext_vector_type(2)));
typedef __bf16 bf16x2_t __attribute__((ext_vector_type(2)));
__device__ __forceinline__ unsigned pk2(float lo, float hi) { const f32x2_t v = {lo, hi}; const bf16x2_t b = __builtin_convertvector(v, bf16x2_t); return __builtin_bit_cast(unsigned, b); }
#define XB_TMO      128
#define XB_XCNT(j)  (256  + 64 * (j))
#define XB_XSUB(j)  (1280 + 64 * (j))
#define XB_XGEN(j)  (2304 + 64 * (j))
#define XB_TOP      3328
#define XB_TOPGEN   3392
#define XCD_BAR_WORDS 3456
#define XB_SPIN_CAP (1u << 18)

__device__ __forceinline__ unsigned xb_ld(unsigned* p)              { return __hip_atomic_load(p, __ATOMIC_RELAXED, __HIP_MEMORY_SCOPE_AGENT); }
__device__ __forceinline__ unsigned xb_add(unsigned* p, unsigned v) { return __hip_atomic_fetch_add(p, v, __ATOMIC_RELAXED, __HIP_MEMORY_SCOPE_AGENT); }
__device__ __forceinline__ unsigned xb_xcc_id() { return (unsigned)__builtin_amdgcn_s_getreg((3 << 11) | 20) & 0xFu; }
#define XB_SPIN(cond, bar) do { unsigned _sp = 0; while (cond) { __builtin_amdgcn_s_sleep(1); \
    if ((++_sp & 255u) == 0u) { if (xb_ld(&(bar)[XB_TMO])) break; if (_sp > XB_SPIN_CAP) { atomicAdd(&(bar)[XB_TMO], 1u); break; } } } } while (0)

struct XcdBarrier {
    unsigned* bar; unsigned x;
    volatile LAS unsigned* st;
};

__device__ __forceinline__ XcdBarrier xcd_barrier_post(unsigned* bar, volatile LAS unsigned* st) {
    XcdBarrier b; b.bar = bar; b.x = xb_xcc_id(); b.st = st;
    if (threadIdx.x == 0) (void)xb_add(&bar[XB_XCNT(b.x)], 1u);
    return b;
}
__device__ __forceinline__ void xcd_barrier_complete(unsigned* bar, unsigned x, unsigned& nloc, unsigned& nx) {
    const unsigned G = gridDim.x * gridDim.y * gridDim.z;
    unsigned sum, cnt, mine, sp = 0u;
    for (;;) {
        sum = 0u; cnt = 0u; mine = 0u;
#pragma unroll
        for (unsigned j = 0; j < 16; ++j) { const unsigned c = xb_ld(&bar[XB_XCNT(j)]); sum += c; cnt += (c > 0u) ? 1u : 0u; mine = (j == x) ? c : mine; }
        if (sum == G) break;
        __builtin_amdgcn_s_sleep(1);
        if ((++sp & 255u) == 0u) { if (xb_ld(&bar[XB_TMO])) break; if (sp > XB_SPIN_CAP) { atomicAdd(&bar[XB_TMO], 1u); break; } }
    }
    nloc = mine > 0u ? mine : 1u; nx = cnt > 0u ? cnt : 1u;
}

__device__ __forceinline__ void xcd_barrier(const XcdBarrier& b) {
    asm volatile("s_waitcnt vmcnt(0)" ::: "memory");
    __syncthreads();
    if (threadIdx.x == 0) {
        unsigned* bar = b.bar;
        __builtin_amdgcn_s_waitcnt(0);
        unsigned nloc = b.st[0], nx = b.st[1];
        if (nloc == 0u) { xcd_barrier_complete(bar, b.x, nloc, nx); b.st[0] = nloc; b.st[1] = nx; }
        const unsigned old = xb_add(&bar[XB_XSUB(b.x)], 1u);
        const unsigned gen = old / nloc;
        if (old + 1u == (gen + 1u) * nloc) {
            __builtin_amdgcn_fence(__ATOMIC_RELEASE, "agent");
            asm volatile("s_waitcnt vmcnt(0)" ::: "memory");
            const unsigned og = xb_add(&bar[XB_TOP], 1u);
            const unsigned tg = og / nx;
            if (og + 1u == (tg + 1u) * nx) {
                xb_add(&bar[XB_TOPGEN], 1u); xb_add(&bar[XB_XGEN(b.x)], 1u);
                __builtin_amdgcn_fence(__ATOMIC_ACQUIRE, "agent");
            } else {
                __builtin_amdgcn_fence(__ATOMIC_ACQUIRE, "agent");
                XB_SPIN(xb_ld(&bar[XB_TOPGEN]) == tg, bar);
                xb_add(&bar[XB_XGEN(b.x)], 1u);
            }
            asm volatile("s_waitcnt vmcnt(0)" ::: "memory");
        } else {
            __builtin_amdgcn_fence(__ATOMIC_ACQUIRE, "agent");
            XB_SPIN(xb_ld(&bar[XB_XGEN(b.x)]) == gen, bar);
            asm volatile("s_waitcnt vmcnt(0)" ::: "memory");
        }
    }
    __syncthreads();
}
struct Args { const float* in[19]; float* out; unsigned char* ws; int ph_lo, ph_hi, li, pad; };
struct Frame {
    LAS unsigned char* lds; int tid, lane, wave, G, bx;
};
__device__ __forceinline__ float wave_sum(float v) {
#pragma unroll
    for (int o = 1; o < 64; o <<= 1) v += __shfl_xor(v, o);
    return v;
}
__device__ __forceinline__ int slot5(int i) { return 16 * ((i >> 2) & 1) + 4 * (i >> 3) + (i & 3); }
__device__ __forceinline__ int dest_row(int mode, int c) {
    if (mode == 1) { const int hs = c >= FF ? 1 : 0, j = c - FF * hs; return 256 * (j >> 7) + 128 * hs + (j & 96) + slot5(j & 31); }
    if (mode == 2) { if (c < 1536) return c; if (c < 2048) return (c & ~31) + slot5(c & 31);     const int cc = c - 2048, hs = cc >> 9, j = cc & 511; return 2048 + 256 * (j >> 7) + 128 * hs + (j & 96) + slot5(j & 31); }
    if (mode == 3) return (c & ~31) + slot5(c & 31);
    return c;
}
__device__ __forceinline__ void tr_item(const float* W, int ldw, bf16* WT, size_t ldt, int k0, int n0, int mode, LAS float* scr, int lane) {
#pragma unroll 8
    for (int i = 0; i < 32; ++i) { const int kk = 2 * i + (lane >> 5); scr[kk * 33 + (lane & 31)] = W[(size_t)(k0 + kk) * ldw + n0 + (lane & 31)]; }
    LDS_WAIT(); asm volatile("" ::: "memory");
    const int c = lane & 7;
#pragma unroll
    for (int j = 0; j < 4; ++j) { const int n = (lane >> 3) + 8 * j; const LAS float* s = scr + (8 * c) * 33 + n;
        v4u o; o.x = pk2(s[0 * 33], s[1 * 33]); o.y = pk2(s[2 * 33], s[3 * 33]); o.z = pk2(s[4 * 33], s[5 * 33]); o.w = pk2(s[6 * 33], s[7 * 33]);
        *(v4u*)(WT + (size_t)dest_row(mode, n0 + n) * ldt + k0 + 8 * c) = o; }
    LDS_WAIT(); asm volatile("" ::: "memory");
}
__device__ __forceinline__ void p0_prologue(const Frame& F, const Args& a) {
    unsigned char* ws = a.ws;
    float* mod = (float*)(ws + WS_MISC);
    if (F.bx < NMODC / 64) {
        LAS float* sl = (LAS float*)F.lds;
        for (int i = F.tid; i < 3 * D; i += NWAVES * 64) { const int r = i >> 10, k = i & 1023; const float c = (r == 0) ? a.in[5][k] : a.in[2][(r - 1) * D + k]; sl[i] = c / (1.0f + __expf(-c)); }
        __syncthreads();
        for (int it = F.bx; it < NMODC / 64; it += F.G) {
            const float* w = a.in[6] + (size_t)(128 * F.wave) * NMODC + it * 64 + F.lane;
            float a0 = 0.f, a1 = 0.f, a2 = 0.f;
#pragma unroll 16
            for (int k = 0; k < 128; ++k) { const float wv = w[(size_t)k * NMODC]; const int kk = 128 * F.wave + k; a0 += sl[kk] * wv; a1 += sl[D + kk] * wv; a2 += sl[2 * D + kk] * wv; }
            LAS float* red = (LAS float*)(F.lds + 16384);
            red[(F.wave * 3 + 0) * 64 + F.lane] = a0; red[(F.wave * 3 + 1) * 64 + F.lane] = a1; red[(F.wave * 3 + 2) * 64 + F.lane] = a2;
            __syncthreads();
            if (F.tid < 192) { const int r = F.tid >> 6, l = F.tid & 63; float s = a.in[7][it * 64 + l];
#pragma unroll
                for (int w8 = 0; w8 < 8; ++w8) s += red[(w8 * 3 + r) * 64 + l];
                mod[r * NMODC + it * 64 + l] = s; }
            __syncthreads();
        }
    }
    if (F.bx == F.G - 1) {
        float* rc = (float*)(ws + WS_MISC + 128 * 1024); float* rs = rc + 1024;
        for (int i = F.tid; i < 1024; i += NWAVES * 64) { const int pos = i >> 4, f = i & 15; const float fr = powf(10000.0f, -(float)(2 * f) / 32.0f); float sn, cs; sincosf((float)pos * fr, &sn, &cs); rc[i] = cs; rs[i] = sn; }
    }
    __syncthreads();
    LAS float* scr = (LAS float*)(F.lds + F.wave * 16384);
    const int gw = F.bx * NWAVES + F.wave, NGW = F.G * NWAVES;
    constexpr int I_UP = (D / 64) * (NUP / 32);
    const int h0 = (F.G >= 2 * (NMODC / 64) - 32) ? NMODC / 64 : 0;
    if (F.bx >= h0) for (int r = (F.bx - h0) * NWAVES + F.wave; r < I_UP; r += (F.G - h0) * NWAVES) tr_item(a.in[10], NUP, (bf16*)(ws + WS_W1U), D, 64 * (r / (NUP / 32)), 32 * (r % (NUP / 32)), 1, scr, F.lane);
}
__device__ __forceinline__ void deferred_items(const Frame& F, const Args& a, int set, int hw, int NHW) {
    unsigned char* ws = a.ws;
    LAS float* scr = (LAS float*)(F.lds + F.wave * 16384);
    constexpr int I_UP = (D / 64) * (NUP / 32), I_DN = (FF / 64) * (D / 32), I_IN = (D / 64) * (NIN / 32), I_O = (D / 64) * (D / 32), I_CV = (PAST / 64) * (AW / 32);
    if (set == 0) { for (int r = hw; r < I_DN; r += NHW) tr_item(a.in[11], D, (bf16*)(ws + WS_W1D), FF, 64 * (r / (D / 32)), 32 * (r % (D / 32)), 3, scr, F.lane); return; }
    constexpr int NITEMS = I_UP + I_DN + I_IN + I_O + 2 * I_CV;
    for (int it = hw; it < NITEMS; it += NHW) {
        int r = it;
        if (r < I_UP) { tr_item(a.in[12], NUP, (bf16*)(ws + WS_W2U), D, 64 * (r / (NUP / 32)), 32 * (r % (NUP / 32)), 1, scr, F.lane); continue; } r -= I_UP;
        if (r < I_DN) { tr_item(a.in[13], D, (bf16*)(ws + WS_W2D), FF, 64 * (r / (D / 32)), 32 * (r % (D / 32)), 3, scr, F.lane); continue; } r -= I_DN;
        if (r < I_IN) { tr_item(a.in[14], NIN, (bf16*)(ws + WS_WIN), D, 64 * (r / (NIN / 32)), 32 * (r % (NIN / 32)), 2, scr, F.lane); continue; } r -= I_IN;
        if (r < I_O) { tr_item(a.in[18], D, (bf16*)(ws + WS_WO), D, 64 * (r / (D / 32)), 32 * (r % (D / 32)), 3, scr, F.lane); continue; } r -= I_O;
        { const int b = r / I_CV; r -= b * I_CV;
          tr_item(a.in[4] + (size_t)b * PAST * AW, AW, (bf16*)(ws + WS_VTLAT) + (size_t)b * AW * TKL, TKL, 64 * (r / (AW / 32)), 32 * (r % (AW / 32)), 0, scr, F.lane); }
    }
    for (int i = hw * 64 + F.lane; i < 2 * PAST * AW / 4; i += NHW * 64) {
        const int e = i * 4, b = e / (PAST * AW), rem = e - b * (PAST * AW);
        const f32x4 v = *(const f32x4*)(a.in[3] + e); v2u o; o.x = pk2(v[0], v[1]); o.y = pk2(v[2], v[3]);
        const int d = rem & 31, remp = (rem & ~31) + 8 * ((d >> 2) & 3) + 4 * (d >> 4);
        *(v2u*)((bf16*)(ws + WS_KLAT) + (size_t)b * TKL * AW + remp) = o; }
}
__device__ __forceinline__ const float* xrow_in(const Args& a, int m) { return m < MC ? a.in[0] + (size_t)m * D : a.in[1] + (size_t)(m - MC) * D; }
__device__ __forceinline__ int modrow(int m) { return m < MC ? 0 : 1 + ((m - MC) >> 10); }
__device__ __forceinline__ void norm_mod_store(const f32x4 (&x)[4], const float* g, const float* sh, const float* sc, bf16* urow, int lane) {
    float ss = 0.f;
#pragma unroll
    for (int j = 0; j < 4; ++j) ss += (x[j][0] * x[j][0] + x[j][1] * x[j][1]) + (x[j][2] * x[j][2] + x[j][3] * x[j][3]);
    const float rstd = 1.0f / sqrtf(wave_sum(ss) * (1.0f / D) + EPS);
#pragma unroll
    for (int j = 0; j < 4; ++j) { const int c = 4 * (lane + 64 * j); const f32x4 gv = *(const f32x4*)(g + c), sv = *(const f32x4*)(sh + c), cv = *(const f32x4*)(sc + c);
        const f32x4 u = x[j] * rstd * gv * (cv + 1.0f) + sv; v2u o; o.x = pk2(u[0], u[1]); o.y = pk2(u[2], u[3]); *(v2u*)(urow + c) = o; }
}
__device__ __forceinline__ void row_phase(const Frame& F, const Args& a, int sub) {
    unsigned char* ws = a.ws; const float* mod = (const float*)(ws + WS_MISC);
    const bf16* Y = (const bf16*)(ws + WS_Y); bf16* X1 = (bf16*)(ws + WS_X1); bf16* U = (bf16*)(ws + WS_U);
    const int gw = F.bx * NWAVES + F.wave, NGW = F.G * NWAVES, lane = F.lane;
    int rcur = -1; f32x4 A[4], B[4], C[4];
    for (int m = gw; m < M; m += NGW) {
        const int r = modrow(m);
        if (r != rcur) { rcur = r; const float* mr = mod + r * NMODC;
#pragma unroll
            for (int j = 0; j < 4; ++j) { const int c = 4 * (lane + 64 * j);
                if (sub >= 1) { const int i = sub - 1; const float gs = (i == 1) ? 1.0f : 0.5f; A[j] = (*(const f32x4*)(mr + (i * 3 + 2) * D + c) * gs) * *(const f32x4*)(a.in[9] + i * D + c); }
                if (sub <= 2) { B[j] = *(const f32x4*)(a.in[8] + sub * D + c) * (*(const f32x4*)(mr + (sub * 3 + 1) * D + c) + 1.0f); C[j] = *(const f32x4*)(mr + (sub * 3 + 0) * D + c); } } }
        f32x4 x[4];
        if (sub <= 1) { const float* xp = xrow_in(a, m);
#pragma unroll
            for (int j = 0; j < 4; ++j) x[j] = *(const f32x4*)(xp + 4 * (lane + 64 * j));
        } else {
#pragma unroll
            for (int j = 0; j < 4; ++j) { const v2u xw = *(const v2u*)(X1 + (size_t)m * D + 4 * (lane + 64 * j)); x[j] = (f32x4){__uint_as_float(xw.x << 16), __uint_as_float(xw.x & 0xffff0000u), __uint_as_float(xw.y << 16), __uint_as_float(xw.y & 0xffff0000u)}; }
        }
        if (sub >= 1) {
            f32x4 y[4]; float ss = 0.f;
#pragma unroll
            for (int j = 0; j < 4; ++j) { const v2u yw = *(const v2u*)(Y + (size_t)m * D + 4 * (lane + 64 * j)); y[j] = (f32x4){__uint_as_float(yw.x << 16), __uint_as_float(yw.x & 0xffff0000u), __uint_as_float(yw.y << 16), __uint_as_float(yw.y & 0xffff0000u)}; ss += (y[j][0] * y[j][0] + y[j][1] * y[j][1]) + (y[j][2] * y[j][2] + y[j][3] * y[j][3]); }
            const float rstd = 1.0f / sqrtf(wave_sum(ss) * (1.0f / D) + EPS);
#pragma unroll
            for (int j = 0; j < 4; ++j) { const int c = 4 * (lane + 64 * j);
                x[j] = x[j] + A[j] * (y[j] * rstd);
                if (sub == 3) *(f32x4*)(a.out + OUT_Y + (size_t)m * D + c) = x[j];
                else { v2u o; o.x = pk2(x[j][0], x[j][1]); o.y = pk2(x[j][2], x[j][3]); *(v2u*)(X1 + (size_t)m * D + c) = o; } }
        }
        if (sub <= 2) {
            float ss = 0.f;
#pragma unroll
            for (int j = 0; j < 4; ++j) ss += (x[j][0] * x[j][0] + x[j][1] * x[j][1]) + (x[j][2] * x[j][2] + x[j][3] * x[j][3]);
            const float rstd = 1.0f / sqrtf(wave_sum(ss) * (1.0f / D) + EPS);
#pragma unroll
            for (int j = 0; j < 4; ++j) { const int c = 4 * (lane + 64 * j); const f32x4 u = (x[j] * rstd) * B[j] + C[j]; v2u o; o.x = pk2(u[0], u[1]); o.y = pk2(u[2], u[3]); *(v2u*)(U + (size_t)m * D + c) = o; }
        }
    }
}
__device__ __forceinline__ float max3f(float a, float b, float c) { float r; asm("v_max3_f32 %0, %1, %2, %3" : "=v"(r) : "v"(a), "v"(b), "v"(c)); return r; }
constexpr int AT_STG = 32768;
static_assert(4 * AT_STG <= RING_BYTES && 4 * 16896 <= RING_BYTES, "attention LDS");
#define AT_WAIT_V(n) asm volatile("s_waitcnt vmcnt(" #n ")" ::: "memory")
template <bool LAT, int VAR = 0>
__device__ __forceinline__ void attn_unit(const Frame& F, const bf16* Qb, const bf16* Kp, const bf16* Vt, int ldv, int T, int qrow0, int h, float lam, const float* subg, bf16* MIX) {
    const int tid = F.tid, lane = F.lane, wid = F.wave, r = lane & 31, hh = lane >> 5, map = wid & 1;
    const int kvh = LAT ? ((wid >> 1) & 1) : 0, qb = LAT ? (wid >> 2) : (wid >> 1);
    const int qrow = qrow0 + 32 * qb + r;
    const bf16* qp = Qb + (size_t)qrow * AW + h * 128 + map * 64 + 8 * hh;
    bf16x8 qf[4];
#pragma unroll
    for (int kk = 0; kk < 4; ++kk) qf[kk] = *(const bf16x8*)(qp + 16 * kk);
    asm volatile("" : "+v"(qf[0]), "+v"(qf[1]), "+v"(qf[2]), "+v"(qf[3]));
    unsigned kgo[2], vgo[2];
#pragma unroll
    for (int i = 0; i < 2; ++i) { const int q = i * 512 + tid;
        { const int key = q >> 4, part = (q & 15) ^ (key & 15); kgo[i] = (unsigned)(key * AW + h * 128 + part * 8); }
        { const int e = q >> 3, part = (q & 7) ^ ((e >> 1) & 7); vgo[i] = (unsigned)((h * 128 + e) * ldv + part * 8); } }
    const unsigned ldsw = (unsigned)wid * 1024u;
#define AT_GLDS_K(s, slot, i_) __builtin_amdgcn_global_load_lds((const unsigned*)(Kp + (size_t)(s) * 64 * AW + kgo[i_]), (LAS unsigned*)(F.lds + (slot) * AT_STG + (i_) * 8192 + ldsw), 16, 0, 0)
#define AT_GLDS_V(s, slot, i_) __builtin_amdgcn_global_load_lds((const unsigned*)(Vt + (s) * 64 + vgo[i_]), (LAS unsigned*)(F.lds + (slot) * AT_STG + 16384 + (i_) * 8192 + ldsw), 16, 0, 0)
#define AT_STAGE(s, slot) do { AT_GLDS_K(s, slot, 0); AT_GLDS_V(s, slot, 0); AT_GLDS_K(s, slot, 1); AT_GLDS_V(s, slot, 1); } while (0)
#define AT_PIN() __builtin_amdgcn_sched_barrier(0)
    const int rp = (r & 19) | ((r & 4) << 1) | ((r & 8) >> 1);
    int kread[4], vread[2];
#pragma unroll
    for (int kk = 0; kk < 4; ++kk) kread[kk] = rp * 256 + (((map * 8 + 2 * kk + hh) ^ (rp & 15)) * 16);
#pragma unroll
    for (int s2 = 0; s2 < 2; ++s2) vread[s2] = 16384 + r * 128 + (((2 * s2 + hh) ^ ((r >> 1) & 7)) * 16);
    f32x16 acc[4];
#pragma unroll
    for (int et = 0; et < 4; ++et)
#pragma unroll
        for (int i = 0; i < 16; ++i) acc[et][i] = 0.f;
    float mrun = -INFINITY, lrun = 0.f;
    __builtin_amdgcn_s_barrier();
    __builtin_amdgcn_sched_barrier(0);
    if (VAR != 1) { AT_STAGE(0, 0); AT_STAGE((T > 1 ? 1 : T - 1), 1); AT_STAGE((T > 2 ? 2 : T - 1), 2); }
    for (int t = 0; t < T; ++t) {
        if (VAR != 1) AT_WAIT_V(8);
        __builtin_amdgcn_s_barrier();
        __builtin_amdgcn_sched_barrier(0);
        const int sn = (t + 3 < T) ? t + 3 : T - 1, sl = (t + 3) & 3;
        const LAS unsigned char* buf = F.lds + (t & 3) * AT_STG;
        if (VAR == 2) AT_STAGE(sn, sl);
#pragma unroll
        for (int jj = 0; jj < (VAR == 2 ? 0 : (LAT ? 1 : 2)); ++jj) {
            const int j = LAT ? kvh : jj;
            bf16x8 kf[4];
#pragma unroll
            for (int kk = 0; kk < 4; ++kk) kf[kk] = *(const LAS bf16x8*)(buf + kread[kk] + j * 32 * 256);
            f32x16 s;
#pragma unroll
            for (int i = 0; i < 16; ++i) s[i] = 0.f;
#pragma unroll
            for (int kk = 0; kk < 4; ++kk) s = __builtin_amdgcn_mfma_f32_32x32x16_bf16(kf[kk], qf[kk], s, 0, 0, 0);
            if (VAR != 1) { AT_PIN(); if (LAT) { AT_GLDS_K(sn, sl, 0); AT_GLDS_V(sn, sl, 0); } else if (jj == 0) AT_GLDS_K(sn, sl, 0); else AT_GLDS_K(sn, sl, 1); AT_PIN(); }
            bf16x8 vf[4][2];
#pragma unroll
            for (int et = 0; et < 4; ++et)
#pragma unroll
                for (int s2 = 0; s2 < 2; ++s2) vf[et][s2] = *(const LAS bf16x8*)(buf + (vread[s2] ^ (j * 64)) + et * 32 * 128);
            float mx = fmaxf(fmaxf(fmaxf(s[0], s[1]), fmaxf(s[2], s[3])), fmaxf(fmaxf(s[4], s[5]), fmaxf(s[6], s[7])));
            mx = fmaxf(mx, fmaxf(fmaxf(fmaxf(s[8], s[9]), fmaxf(s[10], s[11])), fmaxf(fmaxf(s[12], s[13]), fmaxf(s[14], s[15]))));
            mx = fmaxf(mx, mrun);
            const float mnew = fmaxf(mx, __shfl_xor(mx, 32));
            if (__builtin_amdgcn_ballot_w64(mnew > mrun + 8.0f) != 0ull) {
                const float alpha = __builtin_amdgcn_exp2f(mrun - mnew);
                lrun *= alpha;
#pragma unroll
                for (int et = 0; et < 4; ++et) acc[et] = acc[et] * alpha;
                mrun = mnew; }
            float ps = 0.f;
#pragma unroll
            for (int i = 0; i < 16; ++i) { s[i] = __builtin_amdgcn_exp2f(s[i] - mrun); ps += s[i]; }
            lrun += ps;
            bf16x8 pf[2];
#pragma unroll
            for (int s2 = 0; s2 < 2; ++s2) { v4u w; w.x = pk2(s[8 * s2 + 0], s[8 * s2 + 1]); w.y = pk2(s[8 * s2 + 2], s[8 * s2 + 3]); w.z = pk2(s[8 * s2 + 4], s[8 * s2 + 5]); w.w = pk2(s[8 * s2 + 6], s[8 * s2 + 7]); pf[s2] = __builtin_bit_cast(bf16x8, w); }
            if (VAR != 1) { AT_PIN(); if (LAT) { AT_GLDS_K(sn, sl, 1); AT_GLDS_V(sn, sl, 1); } else if (jj == 0) AT_GLDS_V(sn, sl, 0); else AT_GLDS_V(sn, sl, 1); AT_PIN(); }
#pragma unroll
            for (int et = 0; et < 4; ++et)
#pragma unroll
                for (int s2 = 0; s2 < 2; ++s2) acc[et] = __builtin_amdgcn_mfma_f32_32x32x16_bf16(vf[et][s2], pf[s2], acc[et], 0, 0, 0);
        }
    }
    AT_WAIT_V(0);
    __syncthreads();
    if (LAT) {
        LAS float* mb = (LAS float*)(F.lds + (qb * 2 + map) * 16896);
        if (kvh) {
#pragma unroll
            for (int et = 0; et < 4; ++et)
#pragma unroll
                for (int i = 0; i < 16; ++i) mb[(et * 16 + i) * 64 + lane] = acc[et][i];
            mb[4096 + lane] = mrun; mb[4160 + lane] = lrun; }
        __syncthreads();
        if (!kvh) { const float m1 = mb[4096 + lane], l1 = mb[4160 + lane], mt = fmaxf(mrun, m1), a0 = __builtin_amdgcn_exp2f(mrun - mt), a1 = __builtin_amdgcn_exp2f(m1 - mt);
            lrun = lrun * a0 + l1 * a1;
#pragma unroll
            for (int et = 0; et < 4; ++et)
#pragma unroll
                for (int i = 0; i < 16; ++i) acc[et][i] = acc[et][i] * a0 + mb[(et * 16 + i) * 64 + lane] * a1; }
        __syncthreads();
    }
    const float ltot = lrun + __shfl_xor(lrun, 32);
    const float inv = (map ? lam : 1.0f) / ltot;
    LAS float* xb = (LAS float*)(F.lds + qb * 16384);
    if (map && !kvh) {
#pragma unroll
        for (int et = 0; et < 4; ++et)
#pragma unroll
            for (int i = 0; i < 16; ++i) xb[(et * 16 + i) * 64 + lane] = acc[et][i] * inv;
    }
    __syncthreads();
    if (!map && !kvh) {
        f32x4 gv[4][4];
#pragma unroll
        for (int et = 0; et < 4; ++et)
#pragma unroll
            for (int g = 0; g < 4; ++g) gv[et][g] = *(const f32x4*)(subg + 32 * et + 8 * g + 4 * hh);
        float ss = 0.f;
#pragma unroll
        for (int et = 0; et < 4; ++et)
#pragma unroll
            for (int i = 0; i < 16; ++i) { const float o = acc[et][i] * inv - xb[(et * 16 + i) * 64 + lane]; acc[et][i] = o; ss += o * o; }
        ss += __shfl_xor(ss, 32);
        const float rstd = 0.8f / sqrtf(ss * (1.0f / 128.0f) + EPS);
        bf16* op = MIX + (size_t)qrow * D + h * 128 + 4 * hh;
#pragma unroll
        for (int et = 0; et < 4; ++et)
#pragma unroll
            for (int g = 0; g < 4; ++g) { const int e = 32 * et + 8 * g;
                v2u w; w.x = pk2(acc[et][4 * g + 0] * rstd * gv[et][g][0], acc[et][4 * g + 1] * rstd * gv[et][g][1]); w.y = pk2(acc[et][4 * g + 2] * rstd * gv[et][g][2], acc[et][4 * g + 3] * rstd * gv[et][g][3]);
                *(v2u*)(op + e) = w; }
    }
    asm volatile("s_waitcnt vmcnt(0)" ::: "memory");
#undef AT_STAGE
#undef AT_GLDS_K
#undef AT_GLDS_V
#undef AT_PIN
}
__device__ __forceinline__ void attn_conv_phase(const Frame& F, const Args& a, int parts) {
    unsigned char* ws = a.ws;
    const bf16* Qb = (const bf16*)(ws + WS_QB); const bf16* Kctx = (const bf16*)(ws + WS_KCTX); const bf16* Klat = (const bf16*)(ws + WS_KLAT);
    const bf16* Vtctx = (const bf16*)(ws + WS_VTCTX); const bf16* Vtlat = (const bf16*)(ws + WS_VTLAT); bf16* MIX = (bf16*)(ws + WS_MIX);
    const float* lq = a.in[16];
    const float d01 = wave_sum(lq[F.lane] * lq[64 + F.lane]), d23 = wave_sum(lq[128 + F.lane] * lq[192 + F.lane]);
    const float lam = expf(d01) - expf(d23) + 0.2f;
    const int NU = 128 + 256;
    int u = F.bx, ustep = F.G;
    if (F.G == 256 && F.bx >= 128) ustep = 128;
    for (; u < NU; u += ustep) {
        if (F.G == 256 && F.bx < 128 && u >= 128) break;
        if (u < 128 ? !(parts & 1) : !(parts & 2)) continue;
        if (u < 128) { const int bh = u & 7, b = bh >> 2, h = bh & 3, qk = u >> 3;
            if (parts & 8) attn_unit<true, 1>(F, Qb, Klat + (size_t)b * TKL * AW, Vtlat + (size_t)b * AW * TKL, TKL, TKL / 64, MC + b * TL + qk * 64, h, lam, a.in[17], (bf16*)(ws + 216 * MiB));
            else if (parts & 16) attn_unit<true, 2>(F, Qb, Klat + (size_t)b * TKL * AW, Vtlat + (size_t)b * AW * TKL, TKL, TKL / 64, MC + b * TL + qk * 64, h, lam, a.in[17], (bf16*)(ws + 216 * MiB));
            else attn_unit<true>(F, Qb, Klat + (size_t)b * TKL * AW, Vtlat + (size_t)b * AW * TKL, TKL, TKL / 64, MC + b * TL + qk * 64, h, lam, a.in[17], MIX);
        } else { const int uc = u - 128, bh = uc >> 1, b = bh >> 2, h = bh & 3, qk = uc & 1;
            attn_unit<false>(F, Qb, Kctx + (size_t)b * TC * AW, Vtctx + (size_t)b * AW * TC, TC, TC / 64, b * TC + qk * 128, h, lam, a.in[17], MIX); }
    }
    __syncthreads();
    {
        const bf16* BGb = (const bf16*)(ws + WS_BG); const bf16* Zb = (const bf16*)(ws + WS_Z); const float* cw = a.in[15];
        const int t0 = F.bx * NWAVES * 64 + F.tid, tstep = F.G * NWAVES * 64, c = (F.tid & 63) * 8;
        float w0[8], w1[8], w2[8];
#pragma unroll
        for (int j = 0; j < 8; ++j) { w0[j] = cw[c + j]; w1[j] = cw[AW + c + j]; w2[j] = cw[2 * AW + c + j]; }
        constexpr int CB = 5;
        for (int i0 = (parts & 4) ? t0 : M * 64; i0 < M * 64; i0 += CB * tstep) {
            v4u zc[CB], bgv[CB], zp[CB], zn[CB];
#pragma unroll
            for (int k = 0; k < CB; ++k) { const int i = i0 + k * tstep, m = (i < M * 64) ? (i >> 6) : 0;
                const int tl = m < MC ? (m & 255) : ((m - MC) & 1023), T = m < MC ? TC : TL;
                zc[k] = *(const v4u*)(Zb + (size_t)m * AW + c); bgv[k] = *(const v4u*)(BGb + (size_t)m * AW + c);
                zp[k] = *(const v4u*)(Zb + (size_t)(tl > 0 ? m - 1 : m) * AW + c); zn[k] = *(const v4u*)(Zb + (size_t)(tl < T - 1 ? m + 1 : m) * AW + c);
                if (tl == 0) zp[k] = (v4u){0u, 0u, 0u, 0u};
                if (tl == T - 1) zn[k] = (v4u){0u, 0u, 0u, 0u}; }
#pragma unroll
            for (int k = 0; k < CB; ++k) { const int i = i0 + k * tstep; if (i >= M * 64) break; const int m = i >> 6;
                float o[8];
#pragma unroll
                for (int j = 0; j < 8; ++j) {
                    const unsigned sh = (j & 1) * 16;
                    const float fp = __uint_as_float(((zp[k][j >> 1] >> sh) & 0xffffu) << 16), fc = __uint_as_float(((zc[k][j >> 1] >> sh) & 0xffffu) << 16), fn = __uint_as_float(((zn[k][j >> 1] >> sh) & 0xffffu) << 16);
                    const float fb = __uint_as_float(((bgv[k][j >> 1] >> sh) & 0xffffu) << 16);
                    o[j] = fb * (w0[j] * fp + w1[j] * fc + w2[j] * fn); }
                v4u w; w.x = pk2(o[0], o[1]); w.y = pk2(o[2], o[3]); w.z = pk2(o[4], o[5]); w.w = pk2(o[6], o[7]);
                *(v4u*)(MIX + (size_t)m * D + AW + c) = w; }
        }
    }
}
constexpr int NPH = 12;
__global__ void __launch_bounds__(NWAVES * 64, 2) fwd_mk(Args args) {
    extern __shared__ __attribute__((aligned(16))) unsigned char lds[];
    Frame F; F.lds = (LAS unsigned char*)lds; F.tid = threadIdx.x; F.lane = F.tid & 63; F.wave = __builtin_amdgcn_readfirstlane(F.tid >> 6); F.G = gridDim.x; F.bx = blockIdx.x;
    unsigned char* ws = args.ws;
    for (int u = F.tid; u < (LDS_BYTES - LDSCTL_OFF) / 4; u += NWAVES * 64) ((LAS unsigned*)(F.lds + LDSCTL_OFF))[u] = 0u;
    __syncthreads();
    XcdBarrier bar; bar.bar = (unsigned*)(ws + WS_CTL) + CW_BAR; bar.x = 0; bar.st = nullptr;
    if (MK_N_LAUNCHES == 1) bar = xcd_barrier_post((unsigned*)(ws + WS_CTL) + CW_BAR, (volatile LAS unsigned*)(F.lds + MISC_OFF) + 8);
    const int lo = args.ph_lo, hi = args.ph_hi;
#define IN(k) (lo <= (k) && (k) < hi)
#define SEAM(k) do { if (IN(k) && IN((k) + 1)) xcd_barrier(bar); } while (0)
#ifndef PROBE_PARTS
#define PROBE_PARTS 7
#endif
#ifndef PROBE_DUP
#define PROBE_DUP -1
#endif
#define REP(k) for (int rep_ = 0; rep_ < ((k) == PROBE_DUP ? 2 : 1); ++rep_, ((k) == PROBE_DUP && rep_ == 1 ? xcd_barrier(bar) : (void)0))
    bf16* U = (bf16*)(ws + WS_U); bf16* Gb = (bf16*)(ws + WS_G); bf16* Y = (bf16*)(ws + WS_Y);
    if (IN(0)) REP(0) { p0_prologue(F, args); } SEAM(0);
    if (IN(1)) REP(1) { row_phase(F, args, 0); } SEAM(1);
    if (IN(2)) REP(2) { pg8::Gemm g{U, (const bf16*)(ws + WS_W1U), M, NUP, D}; pg8::StaticOrder S; S.init(M, NUP, F.G, F.bx); pg8::EpiSwiGLU E{Gb, FF};
        pg8::gemm_phase<pg8::EpiSwiGLU, pg8::StaticOrder, true, true>(F.lds, g, S, E);
        { const int nwg = (M / 256) * (NUP / 256), c0 = nwg % F.G, h0 = (nwg > F.G) ? c0 : 0;
          if (F.bx >= h0) deferred_items(F, args, 0, (F.bx - h0) * NWAVES + F.wave, (F.G - h0) * NWAVES); } } SEAM(2);
    if (IN(3)) REP(3) { pg8::Gemm g{Gb, (const bf16*)(ws + WS_W1D), M, D, FF}; pg8::StaticOrder S; S.init(M, D, F.G, F.bx); pg8::EpiY E{Y, D};
        pg8::gemm_phase<pg8::EpiY, pg8::StaticOrder, true, true>(F.lds, g, S, E);
        { const int nwg = (M / 256) * (D / 256), h0 = F.G > nwg ? nwg : 0;
          if (F.bx >= h0) deferred_items(F, args, 1, (F.bx - h0) * NWAVES + F.wave, (F.G - h0) * NWAVES); } } SEAM(3);
    if (IN(4)) REP(4) { row_phase(F, args, 1); } SEAM(4);
    if (IN(5)) REP(5) { pg8::Gemm g{U, (const bf16*)(ws + WS_WIN), M, NIN, D}; pg8::StaticOrder S; S.init(M, NIN, F.G, F.bx);
        pg8::EpiMix E{(bf16*)(ws + WS_QB), (bf16*)(ws + WS_KCTX), (bf16*)(ws + WS_KLAT), (bf16*)(ws + WS_VTCTX), (bf16*)(ws + WS_VTLAT), (bf16*)(ws + WS_BG), (bf16*)(ws + WS_Z),
                      args.out + OUT_NK, args.out + OUT_NV, (const float*)(ws + WS_MISC + 128 * 1024), (const float*)(ws + WS_MISC + 128 * 1024) + 1024};
        pg8::gemm_phase<pg8::EpiMix, pg8::StaticOrder, true, true>(F.lds, g, S, E); } SEAM(5);
    if (IN(6)) REP(6) { attn_conv_phase(F, args, 7); } SEAM(6);
    if (IN(7)) REP(7) { pg8::Gemm g{(const bf16*)(ws + WS_MIX), (const bf16*)(ws + WS_WO), M, D, D}; pg8::StaticOrder S; S.init(M, D, F.G, F.bx); pg8::EpiY E{Y, D};
        pg8::gemm_phase<pg8::EpiY, pg8::StaticOrder, true, true>(F.lds, g, S, E); } SEAM(7);
    if (IN(8)) REP(8) { row_phase(F, args, 2); } SEAM(8);
    if (IN(9)) REP(9) { pg8::Gemm g{U, (const bf16*)(ws + WS_W2U), M, NUP, D}; pg8::StaticOrder S; S.init(M, NUP, F.G, F.bx); pg8::EpiSwiGLU E{Gb, FF};
        pg8::gemm_phase<pg8::EpiSwiGLU, pg8::StaticOrder, true, true>(F.lds, g, S, E); } SEAM(9);
    if (IN(10)) REP(10) { pg8::Gemm g{Gb, (const bf16*)(ws + WS_W2D), M, D, FF}; pg8::StaticOrder S; S.init(M, D, F.G, F.bx); pg8::EpiY E{Y, D};
        pg8::gemm_phase<pg8::EpiY, pg8::StaticOrder, true, true>(F.lds, g, S, E); } SEAM(10);
    if (IN(11)) REP(11) { row_phase(F, args, 3); }
#undef IN
#undef SEAM
}

extern "C" void kernel_launch(void* const* d_in, const int* in_sizes, int n_in, void* d_out, int out_size, void* d_ws, size_t ws_size, hipStream_t stream) {
    static int grid = 0;
    if (grid == 0) {
        if (n_in != 19 || ws_size < WS_END) { fprintf(stderr, "kernel_launch: unexpected n_in %d / ws %zu\n", n_in, ws_size); grid = -1; return; }
        int dev = 0, cus = 0, per_cu = 0;
        if (hipGetDevice(&dev) != hipSuccess || hipDeviceGetAttribute(&cus, hipDeviceAttributeMultiprocessorCount, dev) != hipSuccess) { grid = -1; return; }
        if (hipFuncSetAttribute((const void*)fwd_mk, hipFuncAttributeMaxDynamicSharedMemorySize, LDS_BYTES) != hipSuccess) { fprintf(stderr, "kernel_launch: hipFuncSetAttribute failed\n"); grid = -1; return; }
        if (hipOccupancyMaxActiveBlocksPerMultiprocessor(&per_cu, (const void*)fwd_mk, NWAVES * 64, LDS_BYTES) != hipSuccess || per_cu < 1) fprintf(stderr, "kernel_launch: occupancy query says %d\n", per_cu);
        (void)hipGetLastError();
        grid = cus;
    }
    if (grid < 0) return;
    (void)hipMemsetAsync((char*)d_ws + WS_CTL + CW_BAR * 4, 0, XCD_BAR_WORDS * 4, stream);
    Args a{};
    for (int i = 0; i < 19; ++i) a.in[i] = (const float*)d_in[i];
    a.out = (float*)d_out; a.ws = (unsigned char*)d_ws;
#if MK_N_LAUNCHES == 1
    a.ph_lo = 0; a.ph_hi = NPH; a.li = 0;
    void* kargs[] = {&a};
    hipError_t e = hipLaunchCooperativeKernel((const void*)fwd_mk, dim3(grid), dim3(NWAVES * 64), kargs, LDS_BYTES, stream);
    if (e != hipSuccess) fprintf(stderr, "kernel_launch: cooperative launch failed: %s (grid %d)\n", hipGetErrorString(e), grid);
#else
    for (int li = 0; li < NPH; ++li) { a.ph_lo = li; a.ph_hi = li + 1; a.li = li; hipLaunchKernelGGL(fwd_mk, dim3(grid), dim3(NWAVES * 64), LDS_BYTES, stream, a); }
#endif
}
```

```cpp
#include <hip/hip_runtime.h>
#include <hip/hip_cooperative_groups.h>
#include <cstdio>
#include <cstdint>
#ifndef MK_N_LAUNCHES
#define MK_N_LAUNCHES 1
#endif
namespace pg8 {
#define PG8_LAS __attribute__((address_space(3)))
typedef unsigned short bf16_t;
typedef short bf16x8 __attribute__((ext_vector_type(8)));
typedef float f32x4 __attribute__((ext_vector_type(4)));
typedef unsigned u32x4 __attribute__((ext_vector_type(4)));
constexpr int BM = 256, BK = 64, HALF = 128, HTB = HALF * BK * 2  , STAGE_BYTES = 8 * HTB, NXCD = 8, WGM = 8;

__host__ __device__ __forceinline__ int lds_byte(int r, int c) { const int st = (r >> 4) * 2 + (c >> 5), rr = r & 15, cc = c & 31, ob = rr * 64 + cc * 2; return st * 1024 + (ob ^ (((ob >> 9) & 1) << 5)); }
__host__ __device__ __forceinline__ void stage_rc(int b, int& R, int& C) { const int st = b / 1024, sb = b % 1024, swz = sb ^ (((sb >> 9) & 1) << 5); R = (st >> 1) * 16 + swz / 64; C = (st & 1) * 32 + (swz % 64) / 2; }
__host__ __device__ __forceinline__ int perm32(int rho) { const int n = rho >> 4, i = rho & 15; return 8 * (i >> 2) + 4 * n + (i & 3); }

struct Unit { int pm, pn, half; };
struct Gemm { const bf16_t* A; const bf16_t* Bt; int M, N, K; };

struct StaticOrder {
    int nM, nN, nwg, G, c;
    __host__ __device__ void init(int M, int N, int G_, int c_) { nM = M / BM; nN = N / BM; nwg = nM * nN; G = G_; c = c_; }
    __host__ __device__ bool next(int i, Unit& u) const {
        const long L = (long)i * G + c; if (L >= nwg) return false;
        int wgid = (int)L; { const int q = nwg / NXCD, r = nwg % NXCD, xcd = wgid % NXCD, off = wgid / NXCD; wgid = (xcd < r ? xcd * (q + 1) : r * (q + 1) + (xcd - r) * q) + off; }
        const int nig = WGM * nN, gid = wgid / nig, fm = gid * WGM, gsz = (nM - fm) < WGM ? (nM - fm) : WGM;
        u.pm = fm + ((wgid % nig) % gsz); u.pn = (wgid % nig) / gsz; u.half = 0; return true;
    }
    __device__ __forceinline__ void a_ready(const Unit&) const {}
    __device__ __forceinline__ void done(const Unit&) const {}
};
struct TailSplitOrder {
    int nM, nN, nwg, G, c, nfull, nitems;
    __host__ __device__ void init(int M, int N, int G_, int c_) { nM = M / BM; nN = N / BM; nwg = nM * nN; G = G_; c = c_; nfull = (nwg / G) * G; const int rem = nwg - nfull;
        if (2 * rem > G) { nfull = nwg; } nitems = nfull + 2 * (nwg - nfull); }
    __host__ __device__ bool next(int i, Unit& u) const {
        const long L = (long)i * G + c; if (L >= nitems) return false;
        int wgid, half; if (L < nfull) { wgid = (int)L; half = 0; } else { wgid = nfull + (int)(L - nfull) / 2; half = 1 + (int)((L - nfull) & 1); }
        { const int q = nwg / NXCD, r = nwg % NXCD, xcd = wgid % NXCD, off = wgid / NXCD; wgid = (xcd < r ? xcd * (q + 1) : r * (q + 1) + (xcd - r) * q) + off; }
        const int nig = WGM * nN, gid = wgid / nig, fm = gid * WGM, gsz = (nM - fm) < WGM ? (nM - fm) : WGM;
        u.pm = fm + ((wgid % nig) % gsz); u.pn = (wgid % nig) / gsz; u.half = half; return true;
    }
    __device__ __forceinline__ void a_ready(const Unit&) const {}
    __device__ __forceinline__ void done(const Unit&) const {}
};
typedef float f32x2c __attribute__((ext_vector_type(2))); typedef __bf16 bf16x2c __attribute__((ext_vector_type(2)));
__device__ __forceinline__ unsigned cvt_pk_bf16(float lo, float hi) { const f32x2c v = {lo, hi}; const bf16x2c b = __builtin_convertvector(v, bf16x2c); return __builtin_bit_cast(unsigned, b); }
typedef float f32x2 __attribute__((ext_vector_type(2)));
typedef unsigned u32x2 __attribute__((ext_vector_type(2)));
__device__ __forceinline__ f32x4 silu_mul(f32x4 a, f32x4 b) {
    f32x4 o;
#pragma unroll
    for (int j = 0; j < 4; ++j) { const float e = __builtin_amdgcn_exp2f(a[j] * -1.4426950408889634f); o[j] = a[j] * b[j] * __builtin_amdgcn_rcpf(1.0f + e); }
    return o;
}
struct EpiSwiGLU {
    static constexpr bool PERM = false, AFTER_DRAIN = false;
    bf16_t* G; int ldg;
    __device__ __forceinline__ void operator()(const f32x4 (&acc)[2][2][4][2], const Unit& u, int wr, int wc, int fr, int fq) const {
        const int row0 = u.pm * BM + wr * 64 + fr, col0 = u.pn * HALF + wc * 32 + 8 * fq;
#pragma unroll
        for (int ai = 0; ai < 2; ++ai) { if (u.half && u.half != ai + 1) continue;
#pragma unroll
            for (int m = 0; m < 4; ++m) {
                const f32x4 g0 = silu_mul(acc[ai][0][m][0], acc[ai][1][m][0]), g1 = silu_mul(acc[ai][0][m][1], acc[ai][1][m][1]);
                u32x4 w; w.x = cvt_pk_bf16(g0[0], g0[1]); w.y = cvt_pk_bf16(g0[2], g0[3]); w.z = cvt_pk_bf16(g1[0], g1[1]); w.w = cvt_pk_bf16(g1[2], g1[3]);
                *(u32x4*)(G + (size_t)(row0 + ai * HALF + m * 16) * ldg + col0) = w; } }
    }
};
struct EpiY {
    static constexpr bool PERM = false, AFTER_DRAIN = false;
    bf16_t* C; int ldc;
    __device__ __forceinline__ void operator()(const f32x4 (&acc)[2][2][4][2], const Unit& u, int wr, int wc, int fr, int fq) const {
        const int row0 = u.pm * BM + wr * 64 + fr, col0 = u.pn * BM + wc * 32 + 8 * fq;
#pragma unroll
        for (int ai = 0; ai < 2; ++ai)
#pragma unroll
            for (int m = 0; m < 4; ++m) { bf16_t* rowp = C + (size_t)(row0 + ai * HALF + m * 16) * ldc + col0;
#pragma unroll
                for (int bj = 0; bj < 2; ++bj) { const f32x4 v0 = acc[ai][bj][m][0], v1 = acc[ai][bj][m][1];
                    u32x4 w; w.x = cvt_pk_bf16(v0[0], v0[1]); w.y = cvt_pk_bf16(v0[2], v0[3]); w.z = cvt_pk_bf16(v1[0], v1[1]); w.w = cvt_pk_bf16(v1[2], v1[3]); *(u32x4*)(rowp + bj * HALF) = w; } }
    }
};
struct EpiMix {
    static constexpr bool PERM = false, AFTER_DRAIN = false;
    bf16_t *Qb, *Kctx, *Klat, *Vtctx, *Vtlat, *BGb, *Zb; float *newk, *newv; const float *ropeC, *ropeS;
    __device__ __forceinline__ void operator()(const f32x4 (&acc)[2][2][4][2], const Unit& u, int wr, int wc, int fr, int fq) const {
        const int pn = u.pn, pm = u.pm; const bool lat = pm >= 32;
        const int lb = (pm - 32) >> 2, lt0 = ((pm - 32) & 3) * 256;
        const float C2 = 0.125f * 1.4426950408889634f;
        if (pn < 4) {
            const bool isk = pn >= 2; const int colbase = (pn & 1) * 256 + wc * 32 + 4 * fq;
#pragma unroll
            for (int ai = 0; ai < 2; ++ai)
#pragma unroll
                for (int m = 0; m < 4; ++m) {
                    const int rl = wr * 64 + fr + ai * HALF + m * 16, R = pm * BM + rl, t = lt0 + rl;
                    f32x4 c4 = {1.f, 1.f, 1.f, 1.f}, s4 = {0.f, 0.f, 0.f, 0.f};
                    if (lat) { const int pos = (wc & 1) ? (t & 63) : (t >> 6); c4 = *(const f32x4*)(ropeC + pos * 16 + 4 * fq); s4 = *(const f32x4*)(ropeS + pos * 16 + 4 * fq); }
                    bf16_t* dst = !isk ? Qb + (size_t)R * 512 : (lat ? Klat + (size_t)(lb * 1536 + 512 + t) * 512 : Kctx + (size_t)R * 512);
#pragma unroll
                    for (int bj = 0; bj < 2; ++bj) {
                        f32x4 x1 = acc[ai][bj][m][0], x2 = acc[ai][bj][m][1];
                        const int col = colbase + bj * HALF;
                        if (isk && !lat) { *(f32x4*)(newk + (size_t)R * 512 + col) = x1; *(f32x4*)(newk + (size_t)R * 512 + col + 16) = x2; }
                        const f32x4 y1 = x1 * c4 - x2 * s4, y2 = x2 * c4 + x1 * s4; x1 = y1; x2 = y2;
                        if (!isk) { x1 = x1 * C2; x2 = x2 * C2; }
                        u32x4 w; w.x = cvt_pk_bf16(x1[0], x1[1]); w.y = cvt_pk_bf16(x1[2], x1[3]); w.z = cvt_pk_bf16(x2[0], x2[1]); w.w = cvt_pk_bf16(x2[2], x2[3]);
                        *(u32x4*)(dst + (pn & 1) * 256 + bj * HALF + wc * 32 + 8 * fq) = w; } }
        } else if (pn < 6) {
            const int colbase = (pn - 4) * 256 + wc * 32 + 4 * fq;
#pragma unroll
            for (int ai = 0; ai < 2; ++ai)
#pragma unroll
                for (int m = 0; m < 4; ++m) {
                    const int rl = wr * 64 + fr + ai * HALF + m * 16, R = pm * BM + rl, t = lt0 + rl;
                    bf16_t* vt = lat ? Vtlat + (size_t)(lb * 512) * 1536 + 512 + t : Vtctx + (size_t)(pm * 512) * 256 + rl;
                    const size_t ldv = lat ? 1536 : 256;
#pragma unroll
                    for (int bj = 0; bj < 2; ++bj)
#pragma unroll
                        for (int n = 0; n < 2; ++n) { const f32x4 v = acc[ai][bj][m][n]; const int col = colbase + bj * HALF + n * 16;
                            if (!lat) *(f32x4*)(newv + (size_t)R * 512 + col) = v;
                            const unsigned p01 = cvt_pk_bf16(v[0], v[1]), p23 = cvt_pk_bf16(v[2], v[3]);
                            vt[(size_t)(col + 0) * ldv] = (bf16_t)(p01 & 0xffffu); vt[(size_t)(col + 1) * ldv] = (bf16_t)(p01 >> 16);
                            vt[(size_t)(col + 2) * ldv] = (bf16_t)(p23 & 0xffffu); vt[(size_t)(col + 3) * ldv] = (bf16_t)(p23 >> 16); } }
        } else if (pn < 8) {
            const int colbase = (pn - 6) * 256 + wc * 32 + 8 * fq;
#pragma unroll
            for (int ai = 0; ai < 2; ++ai)
#pragma unroll
                for (int m = 0; m < 4; ++m) { bf16_t* dst = BGb + (size_t)(pm * BM + wr * 64 + fr + ai * HALF + m * 16) * 512 + colbase;
#pragma unroll
                    for (int bj = 0; bj < 2; ++bj) { const f32x4 v0 = acc[ai][bj][m][0], v1 = acc[ai][bj][m][1];
                        u32x4 w; w.x = cvt_pk_bf16(v0[0], v0[1]); w.y = cvt_pk_bf16(v0[2], v0[3]); w.z = cvt_pk_bf16(v1[0], v1[1]); w.w = cvt_pk_bf16(v1[2], v1[3]); *(u32x4*)(dst + bj * HALF) = w; } }
        } else {
            const int col0 = (pn - 8) * HALF + wc * 32 + 8 * fq;
#pragma unroll
            for (int ai = 0; ai < 2; ++ai)
#pragma unroll
                for (int m = 0; m < 4; ++m) { const f32x4 z0 = acc[ai][0][m][0] * acc[ai][1][m][0], z1 = acc[ai][0][m][1] * acc[ai][1][m][1];
                    u32x4 w; w.x = cvt_pk_bf16(z0[0], z0[1]); w.y = cvt_pk_bf16(z0[2], z0[3]); w.z = cvt_pk_bf16(z1[0], z1[1]); w.w = cvt_pk_bf16(z1[2], z1[3]);
                    *(u32x4*)(Zb + (size_t)(pm * BM + wr * 64 + fr + ai * HALF + m * 16) * 512 + col0) = w; }
        }
    }
};
template <class Epi, class Sched, bool ALIGN_EPI = false, bool SP2 = false, bool HALFABLE = false>
__device__ __forceinline__ void gemm_phase(PG8_LAS unsigned char* lds, const Gemm g, const Sched& S, const Epi& E) {
    const int tid = threadIdx.x, wid = __builtin_amdgcn_readfirstlane(tid >> 6), lane = tid & 63, wr = wid >> 2, wc = wid & 3, fr = lane & 15, fq = lane >> 4;
    const int K = g.K, nt = K / BK;
    unsigned voffA[2], voffB[2];
#pragma unroll
    for (int i = 0; i < 2; ++i) { int R, C; stage_rc(tid * 16 + i * 8192, R, C); const int Rb = Epi::PERM ? ((R & ~31) + perm32(R & 31)) : R;
        voffA[i] = (unsigned)(R * K + C) * 2u; voffB[i] = (unsigned)(Rb * K + C) * 2u; }
    const size_t kstep = (size_t)(BK * 2);
    const size_t hstep = (size_t)HALF * K * 2;
    const size_t tstep = 2 * hstep;
    const unsigned ldsw = (unsigned)wid * 1024u;
    const int aoff = lds_byte(wr * 64 + fr, fq * 8), boff = lds_byte(wc * 32 + fr, fq * 8);
#define PG8_SA(b, h) (((b) * 2 + (h)) * HTB)
#define PG8_SB(b, h) ((4 + (b) * 2 + (h)) * HTB)
#define PG8_STAGE(bufoff, gbase, voff) do { _Pragma("unroll") for (int _i = 0; _i < 2; ++_i) \
        __builtin_amdgcn_global_load_lds((const unsigned*)((const char*)(gbase) + (voff)[_i]), (PG8_LAS unsigned*)(lds + (bufoff) + ldsw + _i * 8192), 16, 0, 0); } while (0)
#define PG8_LDA(dst, b, h) do { _Pragma("unroll") for (int m = 0; m < 4; ++m) _Pragma("unroll") for (int k = 0; k < 2; ++k) dst[m][k] = *(const PG8_LAS bf16x8*)(lds + PG8_SA(b, h) + aoff + m * 2048 + k * 1024); } while (0)
#define PG8_LDB(dst, b, h) do { _Pragma("unroll") for (int n = 0; n < 2; ++n) _Pragma("unroll") for (int k = 0; k < 2; ++k) dst[n][k] = *(const PG8_LAS bf16x8*)(lds + PG8_SB(b, h) + boff + n * 2048 + k * 1024); } while (0)
#define PG8_MMA(ai, bj, At, Bt) do { __builtin_amdgcn_s_setprio(1); _Pragma("unroll") for (int m = 0; m < 4; ++m) _Pragma("unroll") for (int n = 0; n < 2; ++n) _Pragma("unroll") for (int k = 0; k < 2; ++k) \
        acc[ai][bj][m][n] = __builtin_amdgcn_mfma_f32_16x16x32_bf16(Bt[n][k], At[m][k], acc[ai][bj][m][n], 0, 0, 0); __builtin_amdgcn_s_setprio(0); } while (0)
#define PG8_WAIT_V(n) asm volatile("s_waitcnt vmcnt(" #n ")" ::: "memory")
#define PG8_WAIT_L(n) asm volatile("s_waitcnt lgkmcnt(" #n ")" ::: "memory")
#define PG8_BAR __builtin_amdgcn_s_barrier()
#define PG8_SCHED __builtin_amdgcn_sched_barrier(0)
    Unit cur, nxt; int ui = 0;
    if (!S.next(0, cur)) return;
    f32x4 acc[2][2][4][2];
#pragma unroll
    for (int a = 0; a < 2; ++a)
#pragma unroll
        for (int b = 0; b < 2; ++b)
#pragma unroll
            for (int m = 0; m < 4; ++m)
#pragma unroll
                for (int n = 0; n < 2; ++n) acc[a][b][m][n] = (f32x4){0.f, 0.f, 0.f, 0.f};
    bf16x8 At[4][2], B0[2][2], B1[2][2];
    const char* cA = (const char*)g.A + (size_t)cur.pm * tstep; const char* cB = (const char*)g.Bt + (size_t)cur.pn * tstep;
    S.a_ready(cur);
    if constexpr (SP2) {
        PG8_STAGE(PG8_SB(0, 0), cB, voffB); PG8_STAGE(PG8_SB(0, 1), cB + hstep, voffB); PG8_STAGE(PG8_SA(0, 0), cA, voffA); PG8_STAGE(PG8_SA(0, 1), cA + hstep, voffA);
        if (wr == 1) PG8_BAR;
        PG8_WAIT_V(2); PG8_BAR;
        PG8_STAGE(PG8_SB(1, 0), cB + kstep, voffB); PG8_STAGE(PG8_SA(1, 0), cA + kstep, voffA); PG8_STAGE(PG8_SB(1, 1), cB + hstep + kstep, voffB);
        PG8_WAIT_V(6); PG8_BAR;
    } else {
        PG8_STAGE(PG8_SB(0, 0), cB, voffB); PG8_STAGE(PG8_SA(0, 0), cA, voffA); PG8_STAGE(PG8_SB(0, 1), cB + hstep, voffB); PG8_STAGE(PG8_SA(0, 1), cA + hstep, voffA);
        if (wr == 1) PG8_BAR;
        PG8_WAIT_V(4); PG8_BAR;
        PG8_STAGE(PG8_SB(1, 0), cB + kstep, voffB); PG8_STAGE(PG8_SA(1, 0), cA + kstep, voffA); PG8_STAGE(PG8_SB(1, 1), cB + hstep + kstep, voffB);
        PG8_WAIT_V(6); PG8_BAR;
    }
    for (;;) {
        const bool has_next = S.next(ui + 1, nxt);
        const bool do0 = !HALFABLE || cur.half != 2, do1 = !HALFABLE || cur.half != 1;
        const char* nA = has_next ? (const char*)g.A + (size_t)nxt.pm * tstep : cA; const char* nB = has_next ? (const char*)g.Bt + (size_t)nxt.pn * tstep : cB;
        for (int t = 0; t < nt; t += 2) {
            const bool last = (t == nt - 2);
            const char* a1 = cA + (size_t)(t + 1) * kstep;
            const char* a2 = last ? nA : cA + (size_t)(t + 2) * kstep; const char* b2 = last ? nB : cB + (size_t)(t + 2) * kstep;
            const char* a3 = a2 + kstep; const char* b3 = b2 + kstep;
            if (last && has_next) S.a_ready(nxt);
            if constexpr (SP2) {
            PG8_LDB(B0, 0, 0); PG8_LDB(B1, 0, 1); PG8_SCHED; if (do0) PG8_LDA(At, 0, 0); PG8_STAGE(PG8_SA(1, 1), a1 + hstep, voffA);
            PG8_WAIT_V(8); PG8_WAIT_L(0); PG8_BAR; if (do0) { PG8_MMA(0, 0, At, B0); PG8_MMA(0, 1, At, B1); } PG8_BAR; PG8_SCHED;
            if (do1) PG8_LDA(At, 0, 1); PG8_STAGE(PG8_SB(0, 0), b2, voffB); PG8_STAGE(PG8_SB(0, 1), b2 + hstep, voffB); PG8_STAGE(PG8_SA(0, 0), a2, voffA);
            PG8_WAIT_V(8); PG8_WAIT_L(0); PG8_BAR; if (do1) { PG8_MMA(1, 0, At, B0); PG8_MMA(1, 1, At, B1); } PG8_BAR; PG8_SCHED;
            PG8_LDB(B0, 1, 0); PG8_LDB(B1, 1, 1); PG8_SCHED; if (do0) PG8_LDA(At, 1, 0); PG8_STAGE(PG8_SA(0, 1), a2 + hstep, voffA);
            PG8_WAIT_V(8); PG8_WAIT_L(0); PG8_BAR; if (do0) { PG8_MMA(0, 0, At, B0); PG8_MMA(0, 1, At, B1); } PG8_BAR; PG8_SCHED;
            if (do1) PG8_LDA(At, 1, 1); PG8_STAGE(PG8_SB(1, 0), b3, voffB); PG8_STAGE(PG8_SB(1, 1), b3 + hstep, voffB); PG8_STAGE(PG8_SA(1, 0), a3, voffA);
            PG8_WAIT_V(8); PG8_WAIT_L(0); PG8_BAR; if (do1) { PG8_MMA(1, 0, At, B0); PG8_MMA(1, 1, At, B1); } PG8_BAR; PG8_SCHED;
            } else {
            PG8_LDB(B0, 0, 0); PG8_SCHED; PG8_LDA(At, 0, 0); PG8_STAGE(PG8_SA(1, 1), a1 + hstep, voffA);
            PG8_WAIT_L(8); PG8_BAR; PG8_WAIT_L(0); PG8_MMA(0, 0, At, B0); PG8_BAR; PG8_SCHED;
            PG8_LDB(B1, 0, 1); PG8_STAGE(PG8_SB(0, 0), b2, voffB);
            PG8_BAR; PG8_WAIT_L(0); PG8_MMA(0, 1, At, B1); PG8_BAR;
            PG8_LDA(At, 0, 1); PG8_STAGE(PG8_SA(0, 0), a2, voffA);
            PG8_BAR; PG8_WAIT_L(0); PG8_MMA(1, 0, At, B0); PG8_BAR; PG8_SCHED;
            PG8_STAGE(PG8_SB(0, 1), b2 + hstep, voffB);
            PG8_WAIT_V(6); PG8_BAR; PG8_MMA(1, 1, At, B1); PG8_BAR;
            PG8_LDB(B0, 1, 0); PG8_SCHED; PG8_LDA(At, 1, 0); PG8_STAGE(PG8_SA(0, 1), a2 + hstep, voffA);
            PG8_WAIT_L(8); PG8_BAR; PG8_WAIT_L(0); PG8_MMA(0, 0, At, B0); PG8_BAR; PG8_SCHED;
            PG8_LDB(B1, 1, 1); PG8_STAGE(PG8_SB(1, 0), b3, voffB);
            PG8_BAR; PG8_WAIT_L(0); PG8_MMA(0, 1, At, B1); PG8_BAR;
            PG8_LDA(At, 1, 1); PG8_STAGE(PG8_SA(1, 0), a3, voffA);
            PG8_BAR; PG8_WAIT_L(0); PG8_MMA(1, 0, At, B0); PG8_BAR; PG8_SCHED;
            PG8_STAGE(PG8_SB(1, 1), b3 + hstep, voffB);
            PG8_WAIT_V(6); PG8_BAR; PG8_MMA(1, 1, At, B1); PG8_BAR;
            }
        }
        if constexpr (ALIGN_EPI) { if (wr == 0) PG8_BAR; }
        if constexpr (!Epi::AFTER_DRAIN) { E(acc, cur, wr, wc, fr, fq); S.done(cur); }
        if (!has_next) break;
#pragma unroll
        for (int a = 0; a < 2; ++a)
#pragma unroll
            for (int b = 0; b < 2; ++b)
#pragma unroll
                for (int m = 0; m < 4; ++m)
#pragma unroll
                    for (int n = 0; n < 2; ++n) acc[a][b][m][n] = (f32x4){0.f, 0.f, 0.f, 0.f};
        cur = nxt; cA = nA; cB = nB; ++ui;
        if constexpr (ALIGN_EPI) { if (wr == 1) PG8_BAR; }
    }
    PG8_WAIT_V(0);
    if constexpr (!ALIGN_EPI) { if (wr == 0) PG8_BAR; }
    PG8_BAR;
    if constexpr (Epi::AFTER_DRAIN) { E.fused(acc, cur, wr, wc, fr, fq, lds, wid, lane); S.done(cur); }
#undef PG8_SA
#undef PG8_SB
#undef PG8_STAGE
#undef PG8_LDA
#undef PG8_LDB
#undef PG8_MMA
#undef PG8_WAIT_V
#undef PG8_WAIT_L
#undef PG8_BAR
#undef PG8_SCHED
}
}
constexpr int NWAVES = 8;
constexpr int D = 1024, MC = 8192, MLAT = 2048, M = MC + MLAT, FF = 2816, NUP = 2 * FF, NIN = 3072, AW = 512;
constexpr int TC = 256, TL = 1024, PAST = 512, TKL = PAST + TL, NMODC = 9 * D;
constexpr float EPS = 1e-6f;
constexpr size_t OUT_Y = 0, OUT_NK = (size_t)M * D, OUT_NV = OUT_NK + (size_t)MC * AW;
constexpr size_t MiB = 1u << 20, HMiB = 1u << 19;
constexpr size_t WS_CTL = 0, CTL_ZERO_BYTES = 64 * 1024;
constexpr size_t WS_MISC = 1 * MiB;
constexpr size_t WS_W1U = 2 * MiB, WS_W1D = 13 * MiB, WS_W2U = 13 * MiB + 11 * HMiB, WS_W2D = WS_W2U + 11 * MiB, WS_WIN = 35 * MiB, WS_WO = 41 * MiB;
constexpr size_t WS_KLAT = 43 * MiB, WS_VTLAT = 46 * MiB, WS_U = 49 * MiB, WS_Y = 69 * MiB, WS_X1 = 109 * MiB, WS_R = 149 * MiB;
constexpr size_t WS_G = WS_R, WS_QB = WS_R, WS_KCTX = WS_R + 10 * MiB, WS_VTCTX = WS_R + 18 * MiB, WS_BG = WS_R + 26 * MiB, WS_Z = WS_R + 36 * MiB, WS_MIX = WS_R + 46 * MiB;
constexpr size_t WS_END = WS_R + 66 * MiB;
static_assert(WS_W2D + 11 * HMiB == WS_WIN && WS_G + (size_t)M * FF * 2 <= WS_END && WS_END <= 256 * MiB, "ws map");
constexpr int CW_BAR = 1024;
constexpr int RING_BYTES = 131072, LDSCTL_OFF = RING_BYTES, MISC_OFF = LDSCTL_OFF + 320, LDS_BYTES = 147456;

#define GAS __attribute__((address_space(1)))
#define LAS __attribute__((address_space(3)))
typedef unsigned short bf16;
typedef unsigned v4u __attribute__((ext_vector_type(4)));
typedef unsigned v2u __attribute__((ext_vector_type(2)));
typedef float f32x4 __attribute__((ext_vector_type(4)));
typedef float f32x16 __attribute__((ext_vector_type(16)));
typedef short bf16x8 __attribute__((ext_vector_type(8)));
typedef short s16x4 __attribute__((ext_vector_type(4)));
#define LDS_WAIT() asm volatile("s_waitcnt lgkmcnt(0)" ::: "memory")
__device__ __forceinline__ unsigned f2bf(float f) { unsigned u = __builtin_bit_cast(unsigned, f); return (u + 0x7fffu + ((u >> 16) & 1u)) >> 16; }
typedef float f32x2_t __attribute__((ext_vector_type(2)));
typedef __bf16 bf16x2_t __attribute__((ext_vector_type(2)));
__device__ __forceinline__ unsigned pk2(float lo, float hi) { const f32x2_t v = {lo, hi}; const bf16x2_t b = __builtin_convertvector(v, bf16x2_t); return __builtin_bit_cast(unsigned, b); }
#define XB_TMO      128
#define XB_XCNT(j)  (256  + 64 * (j))
#define XB_XSUB(j)  (1280 + 64 * (j))
#define XB_XGEN(j)  (2304 + 64 * (j))
#define XB_TOP      3328
#define XB_TOPGEN   3392
#define XCD_BAR_WORDS 3456
#define XB_SPIN_CAP (1u << 18)

__device__ __forceinline__ unsigned xb_ld(unsigned* p)              { return __hip_atomic_load(p, __ATOMIC_RELAXED, __HIP_MEMORY_SCOPE_AGENT); }
__device__ __forceinline__ unsigned xb_add(unsigned* p, unsigned v) { return __hip_atomic_fetch_add(p, v, __ATOMIC_RELAXED, __HIP_MEMORY_SCOPE_AGENT); }
__device__ __forceinline__ unsigned xb_xcc_id() { return (unsigned)__builtin_amdgcn_s_getreg((3 << 11) | 20) & 0xFu; }
#define XB_SPIN(cond, bar) do { unsigned _sp = 0; while (cond) { __builtin_amdgcn_s_sleep(1); \
    if ((++_sp & 255u) == 0u) { if (xb_ld(&(bar)[XB_TMO])) break; if (_sp > XB_SPIN_CAP) { atomicAdd(&(bar)[XB_TMO], 1u); break; } } } } while (0)

struct XcdBarrier {
    unsigned* bar; unsigned x;
    volatile LAS unsigned* st;
};

__device__ __forceinline__ XcdBarrier xcd_barrier_post(unsigned* bar, volatile LAS unsigned* st) {
    XcdBarrier b; b.bar = bar; b.x = xb_xcc_id(); b.st = st;
    if (threadIdx.x == 0) (void)xb_add(&bar[XB_XCNT(b.x)], 1u);
    return b;
}
__device__ __forceinline__ void xcd_barrier_complete(unsigned* bar, unsigned x, unsigned& nloc, unsigned& nx) {
    const unsigned G = gridDim.x * gridDim.y * gridDim.z;
    unsigned sum, cnt, mine, sp = 0u;
    for (;;) {
        sum = 0u; cnt = 0u; mine = 0u;
#pragma unroll
        for (unsigned j = 0; j < 16; ++j) { const unsigned c = xb_ld(&bar[XB_XCNT(j)]); sum += c; cnt += (c > 0u) ? 1u : 0u; mine = (j == x) ? c : mine; }
        if (sum == G) break;
        __builtin_amdgcn_s_sleep(1);
        if ((++sp & 255u) == 0u) { if (xb_ld(&bar[XB_TMO])) break; if (sp > XB_SPIN_CAP) { atomicAdd(&bar[XB_TMO], 1u); break; } }
    }
    nloc = mine > 0u ? mine : 1u; nx = cnt > 0u ? cnt : 1u;
}

__device__ __forceinline__ void xcd_barrier(const XcdBarrier& b) {
    asm volatile("s_waitcnt vmcnt(0)" ::: "memory");
    __syncthreads();
    if (threadIdx.x == 0) {
        unsigned* bar = b.bar;
        __builtin_amdgcn_s_waitcnt(0);
        unsigned nloc = b.st[0], nx = b.st[1];
        if (nloc == 0u) { xcd_barrier_complete(bar, b.x, nloc, nx); b.st[0] = nloc; b.st[1] = nx; }
        const unsigned old = xb_add(&bar[XB_XSUB(b.x)], 1u);
        const unsigned gen = old / nloc;
        if (old + 1u == (gen + 1u) * nloc) {
            __builtin_amdgcn_fence(__ATOMIC_RELEASE, "agent");
            asm volatile("s_waitcnt vmcnt(0)" ::: "memory");
            const unsigned og = xb_add(&bar[XB_TOP], 1u);
            const unsigned tg = og / nx;
            if (og + 1u == (tg + 1u) * nx) {
                xb_add(&bar[XB_TOPGEN], 1u); xb_add(&bar[XB_XGEN(b.x)], 1u);
                __builtin_amdgcn_fence(__ATOMIC_ACQUIRE, "agent");
            } else {
                __builtin_amdgcn_fence(__ATOMIC_ACQUIRE, "agent");
                XB_SPIN(xb_ld(&bar[XB_TOPGEN]) == tg, bar);
                xb_add(&bar[XB_XGEN(b.x)], 1u);
            }
            asm volatile("s_waitcnt vmcnt(0)" ::: "memory");
        } else {
            __builtin_amdgcn_fence(__ATOMIC_ACQUIRE, "agent");
            XB_SPIN(xb_ld(&bar[XB_XGEN(b.x)]) == gen, bar);
            asm volatile("s_waitcnt vmcnt(0)" ::: "memory");
        }
    }
    __syncthreads();
}
struct Args { const float* in[19]; float* out; unsigned char* ws; int ph_lo, ph_hi, li, pad; };
struct Frame {
    LAS unsigned char* lds; int tid, lane, wave, G, bx;
};
__device__ __forceinline__ float wave_sum(float v) {
#pragma unroll
    for (int o = 1; o < 64; o <<= 1) v += __shfl_xor(v, o);
    return v;
}
__device__ __forceinline__ int slot5(int i) { return 16 * ((i >> 2) & 1) + 4 * (i >> 3) + (i & 3); }
__device__ __forceinline__ int dest_row(int mode, int c) {
    if (mode == 1) { const int hs = c >= FF ? 1 : 0, j = c - FF * hs; return 256 * (j >> 7) + 128 * hs + (j & 96) + slot5(j & 31); }
    if (mode == 2) { if (c < 1536) return c; if (c < 2048) return (c & ~31) + slot5(c & 31);     const int cc = c - 2048, hs = cc >> 9, j = cc & 511; return 2048 + 256 * (j >> 7) + 128 * hs + (j & 96) + slot5(j & 31); }
    if (mode == 3) return (c & ~31) + slot5(c & 31);
    return c;
}
__device__ __forceinline__ void tr_item(const float* W, int ldw, bf16* WT, size_t ldt, int k0, int n0, int mode, LAS float* scr, int lane) {
#pragma unroll 8
    for (int i = 0; i < 32; ++i) { const int kk = 2 * i + (lane >> 5); scr[kk * 33 + (lane & 31)] = W[(size_t)(k0 + kk) * ldw + n0 + (lane & 31)]; }
    LDS_WAIT(); asm volatile("" ::: "memory");
    const int c = lane & 7;
#pragma unroll
    for (int j = 0; j < 4; ++j) { const int n = (lane >> 3) + 8 * j; const LAS float* s = scr + (8 * c) * 33 + n;
        v4u o; o.x = pk2(s[0 * 33], s[1 * 33]); o.y = pk2(s[2 * 33], s[3 * 33]); o.z = pk2(s[4 * 33], s[5 * 33]); o.w = pk2(s[6 * 33], s[7 * 33]);
        *(v4u*)(WT + (size_t)dest_row(mode, n0 + n) * ldt + k0 + 8 * c) = o; }
    LDS_WAIT(); asm volatile("" ::: "memory");
}
__device__ __forceinline__ void p0_prologue(const Frame& F, const Args& a) {
    unsigned char* ws = a.ws;
    float* mod = (float*)(ws + WS_MISC);
    if (F.bx < NMODC / 64) {
        LAS float* sl = (LAS float*)F.lds;
        for (int i = F.tid; i < 3 * D; i += NWAVES * 64) { const int r = i >> 10, k = i & 1023; const float c = (r == 0) ? a.in[5][k] : a.in[2][(r - 1) * D + k]; sl[i] = c / (1.0f + __expf(-c)); }
        __syncthreads();
        for (int it = F.bx; it < NMODC / 64; it += F.G) {
            const float* w = a.in[6] + (size_t)(128 * F.wave) * NMODC + it * 64 + F.lane;
            float a0 = 0.f, a1 = 0.f, a2 = 0.f;
#pragma unroll 16
            for (int k = 0; k < 128; ++k) { const float wv = w[(size_t)k * NMODC]; const int kk = 128 * F.wave + k; a0 += sl[kk] * wv; a1 += sl[D + kk] * wv; a2 += sl[2 * D + kk] * wv; }
            LAS float* red = (LAS float*)(F.lds + 16384);
            red[(F.wave * 3 + 0) * 64 + F.lane] = a0; red[(F.wave * 3 + 1) * 64 + F.lane] = a1; red[(F.wave * 3 + 2) * 64 + F.lane] = a2;
            __syncthreads();
            if (F.tid < 192) { const int r = F.tid >> 6, l = F.tid & 63; float s = a.in[7][it * 64 + l];
#pragma unroll
                for (int w8 = 0; w8 < 8; ++w8) s += red[(w8 * 3 + r) * 64 + l];
                mod[r * NMODC + it * 64 + l] = s; }
            __syncthreads();
        }
    }
    if (F.bx == F.G - 1) {
        float* rc = (float*)(ws + WS_MISC + 128 * 1024); float* rs = rc + 1024;
        for (int i = F.tid; i < 1024; i += NWAVES * 64) { const int pos = i >> 4, f = i & 15; const float fr = powf(10000.0f, -(float)(2 * f) / 32.0f); float sn, cs; sincosf((float)pos * fr, &sn, &cs); rc[i] = cs; rs[i] = sn; }
    }
    __syncthreads();
    LAS float* scr = (LAS float*)(F.lds + F.wave * 16384);
    const int gw = F.bx * NWAVES + F.wave, NGW = F.G * NWAVES;
    constexpr int I_UP = (D / 64) * (NUP / 32);
    const int h0 = (F.G >= 2 * (NMODC / 64) - 32) ? NMODC / 64 : 0;
    if (F.bx >= h0) for (int r = (F.bx - h0) * NWAVES + F.wave; r < I_UP; r += (F.G - h0) * NWAVES) tr_item(a.in[10], NUP, (bf16*)(ws + WS_W1U), D, 64 * (r / (NUP / 32)), 32 * (r % (NUP / 32)), 1, scr, F.lane);
}
__device__ __forceinline__ void deferred_items(const Frame& F, const Args& a, int set, int hw, int NHW) {
    unsigned char* ws = a.ws;
    LAS float* scr = (LAS float*)(F.lds + F.wave * 16384);
    constexpr int I_UP = (D / 64) * (NUP / 32), I_DN = (FF / 64) * (D / 32), I_IN = (D / 64) * (NIN / 32), I_O = (D / 64) * (D / 32), I_CV = (PAST / 64) * (AW / 32);
    if (set == 0) { for (int r = hw; r < I_DN; r += NHW) tr_item(a.in[11], D, (bf16*)(ws + WS_W1D), FF, 64 * (r / (D / 32)), 32 * (r % (D / 32)), 3, scr, F.lane); return; }
    constexpr int NITEMS = I_UP + I_DN + I_IN + I_O + 2 * I_CV;
    for (int it = hw; it < NITEMS; it += NHW) {
        int r = it;
        if (r < I_UP) { tr_item(a.in[12], NUP, (bf16*)(ws + WS_W2U), D, 64 * (r / (NUP / 32)), 32 * (r % (NUP / 32)), 1, scr, F.lane); continue; } r -= I_UP;
        if (r < I_DN) { tr_item(a.in[13], D, (bf16*)(ws + WS_W2D), FF, 64 * (r / (D / 32)), 32 * (r % (D / 32)), 3, scr, F.lane); continue; } r -= I_DN;
        if (r < I_IN) { tr_item(a.in[14], NIN, (bf16*)(ws + WS_WIN), D, 64 * (r / (NIN / 32)), 32 * (r % (NIN / 32)), 2, scr, F.lane); continue; } r -= I_IN;
        if (r < I_O) { tr_item(a.in[18], D, (bf16*)(ws + WS_WO), D, 64 * (r / (D / 32)), 32 * (r % (D / 32)), 3, scr, F.lane); continue; } r -= I_O;
        { const int b = r / I_CV; r -= b * I_CV;
          tr_item(a.in[4] + (size_t)b * PAST * AW, AW, (bf16*)(ws + WS_VTLAT) + (size_t)b * AW * TKL, TKL, 64 * (r / (AW / 32)), 32 * (r % (AW / 32)), 0, scr, F.lane); }
    }
    for (int i = hw * 64 + F.lane; i < 2 * PAST * AW / 4; i += NHW * 64) {
        const int e = i * 4, b = e / (PAST * AW), rem = e - b * (PAST * AW);
        const f32x4 v = *(const f32x4*)(a.in[3] + e); v2u o; o.x = pk2(v[0], v[1]); o.y = pk2(v[2], v[3]);
        const int d = rem & 31, remp = (rem & ~31) + 8 * ((d >> 2) & 3) + 4 * (d >> 4);
        *(v2u*)((bf16*)(ws + WS_KLAT) + (size_t)b * TKL * AW + remp) = o; }
}
__device__ __forceinline__ const float* xrow_in(const Args& a, int m) { return m < MC ? a.in[0] + (size_t)m * D : a.in[1] + (size_t)(m - MC) * D; }
__device__ __forceinline__ int modrow(int m) { return m < MC ? 0 : 1 + ((m - MC) >> 10); }
__device__ __forceinline__ void norm_mod_store(const f32x4 (&x)[4], const float* g, const float* sh, const float* sc, bf16* urow, int lane) {
    float ss = 0.f;
#pragma unroll
    for (int j = 0; j < 4; ++j) ss += (x[j][0] * x[j][0] + x[j][1] * x[j][1]) + (x[j][2] * x[j][2] + x[j][3] * x[j][3]);
    const float rstd = 1.0f / sqrtf(wave_sum(ss) * (1.0f / D) + EPS);
#pragma unroll
    for (int j = 0; j < 4; ++j) { const int c = 4 * (lane + 64 * j); const f32x4 gv = *(const f32x4*)(g + c), sv = *(const f32x4*)(sh + c), cv = *(const f32x4*)(sc + c);
        const f32x4 u = x[j] * rstd * gv * (cv + 1.0f) + sv; v2u o; o.x = pk2(u[0], u[1]); o.y = pk2(u[2], u[3]); *(v2u*)(urow + c) = o; }
}
__device__ __forceinline__ void row_phase(const Frame& F, const Args& a, int sub) {
    unsigned char* ws = a.ws; const float* mod = (const float*)(ws + WS_MISC);
    const bf16* Y = (const bf16*)(ws + WS_Y); bf16* X1 = (bf16*)(ws + WS_X1); bf16* U = (bf16*)(ws + WS_U);
    const int gw = F.bx * NWAVES + F.wave, NGW = F.G * NWAVES, lane = F.lane;
    int rcur = -1; f32x4 A[4], B[4], C[4];
    for (int m = gw; m < M; m += NGW) {
        const int r = modrow(m);
        if (r != rcur) { rcur = r; const float* mr = mod + r * NMODC;
#pragma unroll
            for (int j = 0; j < 4; ++j) { const int c = 4 * (lane + 64 * j);
                if (sub >= 1) { const int i = sub - 1; const float gs = (i == 1) ? 1.0f : 0.5f; A[j] = (*(const f32x4*)(mr + (i * 3 + 2) * D + c) * gs) * *(const f32x4*)(a.in[9] + i * D + c); }
                if (sub <= 2) { B[j] = *(const f32x4*)(a.in[8] + sub * D + c) * (*(const f32x4*)(mr + (sub * 3 + 1) * D + c) + 1.0f); C[j] = *(const f32x4*)(mr + (sub * 3 + 0) * D + c); } } }
        f32x4 x[4];
        if (sub <= 1) { const float* xp = xrow_in(a, m);
#pragma unroll
            for (int j = 0; j < 4; ++j) x[j] = *(const f32x4*)(xp + 4 * (lane + 64 * j));
        } else {
#pragma unroll
            for (int j = 0; j < 4; ++j) { const v2u xw = *(const v2u*)(X1 + (size_t)m * D + 4 * (lane + 64 * j)); x[j] = (f32x4){__uint_as_float(xw.x << 16), __uint_as_float(xw.x & 0xffff0000u), __uint_as_float(xw.y << 16), __uint_as_float(xw.y & 0xffff0000u)}; }
        }
        if (sub >= 1) {
            f32x4 y[4]; float ss = 0.f;
#pragma unroll
            for (int j = 0; j < 4; ++j) { const v2u yw = *(const v2u*)(Y + (size_t)m * D + 4 * (lane + 64 * j)); y[j] = (f32x4){__uint_as_float(yw.x << 16), __uint_as_float(yw.x & 0xffff0000u), __uint_as_float(yw.y << 16), __uint_as_float(yw.y & 0xffff0000u)}; ss += (y[j][0] * y[j][0] + y[j][1] * y[j][1]) + (y[j][2] * y[j][2] + y[j][3] * y[j][3]); }
            const float rstd = 1.0f / sqrtf(wave_sum(ss) * (1.0f / D) + EPS);
#pragma unroll
            for (int j = 0; j < 4; ++j) { const int c = 4 * (lane + 64 * j);
                x[j] = x[j] + A[j] * (y[j] * rstd);
                if (sub == 3) *(f32x4*)(a.out + OUT_Y + (size_t)m * D + c) = x[j];
                else { v2u o; o.x = pk2(x[j][0], x[j][1]); o.y = pk2(x[j][2], x[j][3]); *(v2u*)(X1 + (size_t)m * D + c) = o; } }
        }
        if (sub <= 2) {
            float ss = 0.f;
#pragma unroll
            for (int j = 0; j < 4; ++j) ss += (x[j][0] * x[j][0] + x[j][1] * x[j][1]) + (x[j][2] * x[j][2] + x[j][3] * x[j][3]);
            const float rstd = 1.0f / sqrtf(wave_sum(ss) * (1.0f / D) + EPS);
#pragma unroll
            for (int j = 0; j < 4; ++j) { const int c = 4 * (lane + 64 * j); const f32x4 u = (x[j] * rstd) * B[j] + C[j]; v2u o; o.x = pk2(u[0], u[1]); o.y = pk2(u[2], u[3]); *(v2u*)(U + (size_t)m * D + c) = o; }
        }
    }
}
__device__ __forceinline__ float max3f(float a, float b, float c) { float r; asm("v_max3_f32 %0, %1, %2, %3" : "=v"(r) : "v"(a), "v"(b), "v"(c)); return r; }
constexpr int AT_STG = 32768;
static_assert(4 * AT_STG <= RING_BYTES && 4 * 16896 <= RING_BYTES, "attention LDS");
#define AT_WAIT_V(n) asm volatile("s_waitcnt vmcnt(" #n ")" ::: "memory")
template <bool LAT, int VAR = 0>
__device__ __forceinline__ void attn_unit(const Frame& F, const bf16* Qb, const bf16* Kp, const bf16* Vt, int ldv, int T, int qrow0, int h, float lam, const float* subg, bf16* MIX) {
    const int tid = F.tid, lane = F.lane, wid = F.wave, r = lane & 31, hh = lane >> 5, map = wid & 1;
    const int kvh = LAT ? ((wid >> 1) & 1) : 0, qb = LAT ? (wid >> 2) : (wid >> 1);
    const int qrow = qrow0 + 32 * qb + r;
    const bf16* qp = Qb + (size_t)qrow * AW + h * 128 + map * 64 + 8 * hh;
    bf16x8 qf[4];
#pragma unroll
    for (int kk = 0; kk < 4; ++kk) qf[kk] = *(const bf16x8*)(qp + 16 * kk);
    asm volatile("" : "+v"(qf[0]), "+v"(qf[1]), "+v"(qf[2]), "+v"(qf[3]));
    unsigned kgo[2], vgo[2];
#pragma unroll
    for (int i = 0; i < 2; ++i) { const int q = i * 512 + tid;
        { const int key = q >> 4, part = (q & 15) ^ (key & 15); kgo[i] = (unsigned)(key * AW + h * 128 + part * 8); }
        { const int e = q >> 3, part = (q & 7) ^ ((e >> 1) & 7); vgo[i] = (unsigned)((h * 128 + e) * ldv + part * 8); } }
    const unsigned ldsw = (unsigned)wid * 1024u;
#define AT_GLDS_K(s, slot, i_) __builtin_amdgcn_global_load_lds((const unsigned*)(Kp + (size_t)(s) * 64 * AW + kgo[i_]), (LAS unsigned*)(F.lds + (slot) * AT_STG + (i_) * 8192 + ldsw), 16, 0, 0)
#define AT_GLDS_V(s, slot, i_) __builtin_amdgcn_global_load_lds((const unsigned*)(Vt + (s) * 64 + vgo[i_]), (LAS unsigned*)(F.lds + (slot) * AT_STG + 16384 + (i_) * 8192 + ldsw), 16, 0, 0)
#define AT_STAGE(s, slot) do { AT_GLDS_K(s, slot, 0); AT_GLDS_V(s, slot, 0); AT_GLDS_K(s, slot, 1); AT_GLDS_V(s, slot, 1); } while (0)
#define AT_PIN() __builtin_amdgcn_sched_barrier(0)
    const int rp = (r & 19) | ((r & 4) << 1) | ((r & 8) >> 1);
    int kread[4], vread[2];
#pragma unroll
    for (int kk = 0; kk < 4; ++kk) kread[kk] = rp * 256 + (((map * 8 + 2 * kk + hh) ^ (rp & 15)) * 16);
#pragma unroll
    for (int s2 = 0; s2 < 2; ++s2) vread[s2] = 16384 + r * 128 + (((2 * s2 + hh) ^ ((r >> 1) & 7)) * 16);
    f32x16 acc[4];
#pragma unroll
    for (int et = 0; et < 4; ++et)
#pragma unroll
        for (int i = 0; i < 16; ++i) acc[et][i] = 0.f;
    float mrun = -INFINITY, lrun = 0.f;
    __builtin_amdgcn_s_barrier();
    __builtin_amdgcn_sched_barrier(0);
    if (VAR != 1) { AT_STAGE(0, 0); AT_STAGE((T > 1 ? 1 : T - 1), 1); AT_STAGE((T > 2 ? 2 : T - 1), 2); }
    for (int t = 0; t < T; ++t) {
        if (VAR != 1) AT_WAIT_V(8);
        __builtin_amdgcn_s_barrier();
        __builtin_amdgcn_sched_barrier(0);
        const int sn = (t + 3 < T) ? t + 3 : T - 1, sl = (t + 3) & 3;
        const LAS unsigned char* buf = F.lds + (t & 3) * AT_STG;
        if (VAR == 2) AT_STAGE(sn, sl);
#pragma unroll
        for (int jj = 0; jj < (VAR == 2 ? 0 : (LAT ? 1 : 2)); ++jj) {
            const int j = LAT ? kvh : jj;
            bf16x8 kf[4];
#pragma unroll
            for (int kk = 0; kk < 4; ++kk) kf[kk] = *(const LAS bf16x8*)(buf + kread[kk] + j * 32 * 256);
            f32x16 s;
#pragma unroll
            for (int i = 0; i < 16; ++i) s[i] = 0.f;
#pragma unroll
            for (int kk = 0; kk < 4; ++kk) s = __builtin_amdgcn_mfma_f32_32x32x16_bf16(kf[kk], qf[kk], s, 0, 0, 0);
            if (VAR != 1) { AT_PIN(); if (LAT) { AT_GLDS_K(sn, sl, 0); AT_GLDS_V(sn, sl, 0); } else if (jj == 0) AT_GLDS_K(sn, sl, 0); else AT_GLDS_K(sn, sl, 1); AT_PIN(); }
            bf16x8 vf[4][2];
#pragma unroll
            for (int et = 0; et < 4; ++et)
#pragma unroll
                for (int s2 = 0; s2 < 2; ++s2) vf[et][s2] = *(const LAS bf16x8*)(buf + (vread[s2] ^ (j * 64)) + et * 32 * 128);
            float mx = fmaxf(fmaxf(fmaxf(s[0], s[1]), fmaxf(s[2], s[3])), fmaxf(fmaxf(s[4], s[5]), fmaxf(s[6], s[7])));
            mx = fmaxf(mx, fmaxf(fmaxf(fmaxf(s[8], s[9]), fmaxf(s[10], s[11])), fmaxf(fmaxf(s[12], s[13]), fmaxf(s[14], s[15]))));
            mx = fmaxf(mx, mrun);
            const float mnew = fmaxf(mx, __shfl_xor(mx, 32));
            if (__builtin_amdgcn_ballot_w64(mnew > mrun + 8.0f) != 0ull) {
                const float alpha = __builtin_amdgcn_exp2f(mrun - mnew);
                lrun *= alpha;
#pragma unroll
                for (int et = 0; et < 4; ++et) acc[et] = acc[et] * alpha;
                mrun = mnew; }
            float ps = 0.f;
#pragma unroll
            for (int i = 0; i < 16; ++i) { s[i] = __builtin_amdgcn_exp2f(s[i] - mrun); ps += s[i]; }
            lrun += ps;
            bf16x8 pf[2];
#pragma unroll
            for (int s2 = 0; s2 < 2; ++s2) { v4u w; w.x = pk2(s[8 * s2 + 0], s[8 * s2 + 1]); w.y = pk2(s[8 * s2 + 2], s[8 * s2 + 3]); w.z = pk2(s[8 * s2 + 4], s[8 * s2 + 5]); w.w = pk2(s[8 * s2 + 6], s[8 * s2 + 7]); pf[s2] = __builtin_bit_cast(bf16x8, w); }
            if (VAR != 1) { AT_PIN(); if (LAT) { AT_GLDS_K(sn, sl, 1); AT_GLDS_V(sn, sl, 1); } else if (jj == 0) AT_GLDS_V(sn, sl, 0); else AT_GLDS_V(sn, sl, 1); AT_PIN(); }
#pragma unroll
            for (int et = 0; et < 4; ++et)
#pragma unroll
                for (int s2 = 0; s2 < 2; ++s2) acc[et] = __builtin_amdgcn_mfma_f32_32x32x16_bf16(vf[et][s2], pf[s2], acc[et], 0, 0, 0);
        }
    }
    AT_WAIT_V(0);
    __syncthreads();
    if (LAT) {
        LAS float* mb = (LAS float*)(F.lds + (qb * 2 + map) * 16896);
        if (kvh) {
#pragma unroll
            for (int et = 0; et < 4; ++et)
#pragma unroll
                for (int i = 0; i < 16; ++i) mb[(et * 16 + i) * 64 + lane] = acc[et][i];
            mb[4096 + lane] = mrun; mb[4160 + lane] = lrun; }
        __syncthreads();
        if (!kvh) { const float m1 = mb[4096 + lane], l1 = mb[4160 + lane], mt = fmaxf(mrun, m1), a0 = __builtin_amdgcn_exp2f(mrun - mt), a1 = __builtin_amdgcn_exp2f(m1 - mt);
            lrun = lrun * a0 + l1 * a1;
#pragma unroll
            for (int et = 0; et < 4; ++et)
#pragma unroll
                for (int i = 0; i < 16; ++i) acc[et][i] = acc[et][i] * a0 + mb[(et * 16 + i) * 64 + lane] * a1; }
        __syncthreads();
    }
    const float ltot = lrun + __shfl_xor(lrun, 32);
    const float inv = (map ? lam : 1.0f) / ltot;
    LAS float* xb = (LAS float*)(F.lds + qb * 16384);
    if (map && !kvh) {
#pragma unroll
        for (int et = 0; et < 4; ++et)
#pragma unroll
            for (int i = 0; i < 16; ++i) xb[(et * 16 + i) * 64 + lane] = acc[et][i] * inv;
    }
    __syncthreads();
    if (!map && !kvh) {
        f32x4 gv[4][4];
#pragma unroll
        for (int et = 0; et < 4; ++et)
#pragma unroll
            for (int g = 0; g < 4; ++g) gv[et][g] = *(const f32x4*)(subg + 32 * et + 8 * g + 4 * hh);
        float ss = 0.f;
#pragma unroll
        for (int et = 0; et < 4; ++et)
#pragma unroll
            for (int i = 0; i < 16; ++i) { const float o = acc[et][i] * inv - xb[(et * 16 + i) * 64 + lane]; acc[et][i] = o; ss += o * o; }
        ss += __shfl_xor(ss, 32);
        const float rstd = 0.8f / sqrtf(ss * (1.0f / 128.0f) + EPS);
        bf16* op = MIX + (size_t)qrow * D + h * 128 + 8 * hh;
#pragma unroll
        for (int et = 0; et < 4; ++et)
#pragma unroll
            for (int k = 0; k < 2; ++k) {
                v2u pa, pb; { const int g = 2 * k; pa.x = pk2(acc[et][4 * g + 0] * rstd * gv[et][g][0], acc[et][4 * g + 1] * rstd * gv[et][g][1]); pa.y = pk2(acc[et][4 * g + 2] * rstd * gv[et][g][2], acc[et][4 * g + 3] * rstd * gv[et][g][3]); }
                { const int g = 2 * k + 1; pb.x = pk2(acc[et][4 * g + 0] * rstd * gv[et][g][0], acc[et][4 * g + 1] * rstd * gv[et][g][1]); pb.y = pk2(acc[et][4 * g + 2] * rstd * gv[et][g][2], acc[et][4 * g + 3] * rstd * gv[et][g][3]); }
                const auto rx = __builtin_amdgcn_permlane32_swap(pa.x, pb.x, false, false), ry = __builtin_amdgcn_permlane32_swap(pa.y, pb.y, false, false);
                v4u w; w.x = rx[0]; w.y = ry[0]; w.z = rx[1]; w.w = ry[1];
                *(v4u*)(op + 32 * et + 16 * k) = w; }
    }
    asm volatile("s_waitcnt vmcnt(0)" ::: "memory");
#undef AT_STAGE
#undef AT_GLDS_K
#undef AT_GLDS_V
#undef AT_PIN
}
__device__ __forceinline__ void attn_conv_phase(const Frame& F, const Args& a, int parts) {
    unsigned char* ws = a.ws;
    const bf16* Qb = (const bf16*)(ws + WS_QB); const bf16* Kctx = (const bf16*)(ws + WS_KCTX); const bf16* Klat = (const bf16*)(ws + WS_KLAT);
    const bf16* Vtctx = (const bf16*)(ws + WS_VTCTX); const bf16* Vtlat = (const bf16*)(ws + WS_VTLAT); bf16* MIX = (bf16*)(ws + WS_MIX);
    const float* lq = a.in[16];
    const float d01 = wave_sum(lq[F.lane] * lq[64 + F.lane]), d23 = wave_sum(lq[128 + F.lane] * lq[192 + F.lane]);
    const float lam = expf(d01) - expf(d23) + 0.2f;
    const int NU = 128 + 256;
    int u = F.bx, ustep = F.G;
    if (F.G == 256 && F.bx >= 128) ustep = 128;
    for (; u < NU; u += ustep) {
        if (F.G == 256 && F.bx < 128 && u >= 128) break;
        if (u < 128 ? !(parts & 1) : !(parts & 2)) continue;
        if (u < 128) { const int bh = u & 7, b = bh >> 2, h = bh & 3, qk = u >> 3;
            if (parts & 8) attn_unit<true, 1>(F, Qb, Klat + (size_t)b * TKL * AW, Vtlat + (size_t)b * AW * TKL, TKL, TKL / 64, MC + b * TL + qk * 64, h, lam, a.in[17], (bf16*)(ws + 216 * MiB));
            else if (parts & 16) attn_unit<true, 2>(F, Qb, Klat + (size_t)b * TKL * AW, Vtlat + (size_t)b * AW * TKL, TKL, TKL / 64, MC + b * TL + qk * 64, h, lam, a.in[17], (bf16*)(ws + 216 * MiB));
            else attn_unit<true>(F, Qb, Klat + (size_t)b * TKL * AW, Vtlat + (size_t)b * AW * TKL, TKL, TKL / 64, MC + b * TL + qk * 64, h, lam, a.in[17], MIX);
        } else { const int uc = u - 128, bh = uc >> 1, b = bh >> 2, h = bh & 3, qk = uc & 1;
            attn_unit<false>(F, Qb, Kctx + (size_t)b * TC * AW, Vtctx + (size_t)b * AW * TC, TC, TC / 64, b * TC + qk * 128, h, lam, a.in[17], MIX); }
    }
    __syncthreads();
    {
        const bf16* BGb = (const bf16*)(ws + WS_BG); const bf16* Zb = (const bf16*)(ws + WS_Z); const float* cw = a.in[15];
        const int t0 = F.bx * NWAVES * 64 + F.tid, tstep = F.G * NWAVES * 64, c = (F.tid & 63) * 8;
        float w0[8], w1[8], w2[8];
#pragma unroll
        for (int j = 0; j < 8; ++j) { w0[j] = cw[c + j]; w1[j] = cw[AW + c + j]; w2[j] = cw[2 * AW + c + j]; }
        constexpr int CB = 5;
        for (int i0 = (parts & 4) ? t0 : M * 64; i0 < M * 64; i0 += CB * tstep) {
            v4u zc[CB], bgv[CB], zp[CB], zn[CB];
#pragma unroll
            for (int k = 0; k < CB; ++k) { const int i = i0 + k * tstep, m = (i < M * 64) ? (i >> 6) : 0;
                const int tl = m < MC ? (m & 255) : ((m - MC) & 1023), T = m < MC ? TC : TL;
                zc[k] = *(const v4u*)(Zb + (size_t)m * AW + c); bgv[k] = *(const v4u*)(BGb + (size_t)m * AW + c);
                zp[k] = *(const v4u*)(Zb + (size_t)(tl > 0 ? m - 1 : m) * AW + c); zn[k] = *(const v4u*)(Zb + (size_t)(tl < T - 1 ? m + 1 : m) * AW + c);
                if (tl == 0) zp[k] = (v4u){0u, 0u, 0u, 0u};
                if (tl == T - 1) zn[k] = (v4u){0u, 0u, 0u, 0u}; }
#pragma unroll
            for (int k = 0; k < CB; ++k) { const int i = i0 + k * tstep; if (i >= M * 64) break; const int m = i >> 6;
                float o[8];
#pragma unroll
                for (int j = 0; j < 8; ++j) {
                    const unsigned sh = (j & 1) * 16;
                    const float fp = __uint_as_float(((zp[k][j >> 1] >> sh) & 0xffffu) << 16), fc = __uint_as_float(((zc[k][j >> 1] >> sh) & 0xffffu) << 16), fn = __uint_as_float(((zn[k][j >> 1] >> sh) & 0xffffu) << 16);
                    const float fb = __uint_as_float(((bgv[k][j >> 1] >> sh) & 0xffffu) << 16);
                    o[j] = fb * (w0[j] * fp + w1[j] * fc + w2[j] * fn); }
                v4u w; w.x = pk2(o[0], o[1]); w.y = pk2(o[2], o[3]); w.z = pk2(o[4], o[5]); w.w = pk2(o[6], o[7]);
                *(v4u*)(MIX + (size_t)m * D + AW + c) = w; }
        }
    }
}
constexpr int NPH = 12;
__global__ void __launch_bounds__(NWAVES * 64, 2) fwd_mk(Args args) {
    extern __shared__ __attribute__((aligned(16))) unsigned char lds[];
    Frame F; F.lds = (LAS unsigned char*)lds; F.tid = threadIdx.x; F.lane = F.tid & 63; F.wave = __builtin_amdgcn_readfirstlane(F.tid >> 6); F.G = gridDim.x; F.bx = blockIdx.x;
    unsigned char* ws = args.ws;
    for (int u = F.tid; u < (LDS_BYTES - LDSCTL_OFF) / 4; u += NWAVES * 64) ((LAS unsigned*)(F.lds + LDSCTL_OFF))[u] = 0u;
    __syncthreads();
    XcdBarrier bar; bar.bar = (unsigned*)(ws + WS_CTL) + CW_BAR; bar.x = 0; bar.st = nullptr;
    if (MK_N_LAUNCHES == 1) bar = xcd_barrier_post((unsigned*)(ws + WS_CTL) + CW_BAR, (volatile LAS unsigned*)(F.lds + MISC_OFF) + 8);
    const int lo = args.ph_lo, hi = args.ph_hi;
#define IN(k) (lo <= (k) && (k) < hi)
#define SEAM(k) do { if (IN(k) && IN((k) + 1)) xcd_barrier(bar); } while (0)
#ifndef PROBE_PARTS
#define PROBE_PARTS 7
#endif
#ifndef PROBE_DUP
#define PROBE_DUP -1
#endif
#define REP(k) for (int rep_ = 0; rep_ < ((k) == PROBE_DUP ? 2 : 1); ++rep_, ((k) == PROBE_DUP && rep_ == 1 ? xcd_barrier(bar) : (void)0))
    bf16* U = (bf16*)(ws + WS_U); bf16* Gb = (bf16*)(ws + WS_G); bf16* Y = (bf16*)(ws + WS_Y);
    if (IN(0)) REP(0) { p0_prologue(F, args); } SEAM(0);
    if (IN(1)) REP(1) { row_phase(F, args, 0); } SEAM(1);
    if (IN(2)) REP(2) { pg8::Gemm g{U, (const bf16*)(ws + WS_W1U), M, NUP, D}; pg8::StaticOrder S; S.init(M, NUP, F.G, F.bx); pg8::EpiSwiGLU E{Gb, FF};
        pg8::gemm_phase<pg8::EpiSwiGLU, pg8::StaticOrder, true, true>(F.lds, g, S, E);
        { const int nwg = (M / 256) * (NUP / 256), c0 = nwg % F.G, h0 = (nwg > F.G) ? c0 : 0;
          if (F.bx >= h0) deferred_items(F, args, 0, (F.bx - h0) * NWAVES + F.wave, (F.G - h0) * NWAVES); } } SEAM(2);
    if (IN(3)) REP(3) { pg8::Gemm g{Gb, (const bf16*)(ws + WS_W1D), M, D, FF}; pg8::StaticOrder S; S.init(M, D, F.G, F.bx); pg8::EpiY E{Y, D};
        pg8::gemm_phase<pg8::EpiY, pg8::StaticOrder, true, true>(F.lds, g, S, E);
        { const int nwg = (M / 256) * (D / 256), h0 = F.G > nwg ? nwg : 0;
          if (F.bx >= h0) deferred_items(F, args, 1, (F.bx - h0) * NWAVES + F.wave, (F.G - h0) * NWAVES); } } SEAM(3);
    if (IN(4)) REP(4) { row_phase(F, args, 1); } SEAM(4);
    if (IN(5)) REP(5) { pg8::Gemm g{U, (const bf16*)(ws + WS_WIN), M, NIN, D}; pg8::StaticOrder S; S.init(M, NIN, F.G, F.bx);
        pg8::EpiMix E{(bf16*)(ws + WS_QB), (bf16*)(ws + WS_KCTX), (bf16*)(ws + WS_KLAT), (bf16*)(ws + WS_VTCTX), (bf16*)(ws + WS_VTLAT), (bf16*)(ws + WS_BG), (bf16*)(ws + WS_Z),
                      args.out + OUT_NK, args.out + OUT_NV, (const float*)(ws + WS_MISC + 128 * 1024), (const float*)(ws + WS_MISC + 128 * 1024) + 1024};
        pg8::gemm_phase<pg8::EpiMix, pg8::StaticOrder, true, true>(F.lds, g, S, E); } SEAM(5);
    if (IN(6)) REP(6) { attn_conv_phase(F, args, 7); } SEAM(6);
    if (IN(7)) REP(7) { pg8::Gemm g{(const bf16*)(ws + WS_MIX), (const bf16*)(ws + WS_WO), M, D, D}; pg8::StaticOrder S; S.init(M, D, F.G, F.bx); pg8::EpiY E{Y, D};
        pg8::gemm_phase<pg8::EpiY, pg8::StaticOrder, true, true>(F.lds, g, S, E); } SEAM(7);
    if (IN(8)) REP(8) { row_phase(F, args, 2); } SEAM(8);
    if (IN(9)) REP(9) { pg8::Gemm g{U, (const bf16*)(ws + WS_W2U), M, NUP, D}; pg8::StaticOrder S; S.init(M, NUP, F.G, F.bx); pg8::EpiSwiGLU E{Gb, FF};
        pg8::gemm_phase<pg8::EpiSwiGLU, pg8::StaticOrder, true, true>(F.lds, g, S, E); } SEAM(9);
    if (IN(10)) REP(10) { pg8::Gemm g{Gb, (const bf16*)(ws + WS_W2D), M, D, FF}; pg8::StaticOrder S; S.init(M, D, F.G, F.bx); pg8::EpiY E{Y, D};
        pg8::gemm_phase<pg8::EpiY, pg8::StaticOrder, true, true>(F.lds, g, S, E); } SEAM(10);
    if (IN(11)) REP(11) { row_phase(F, args, 3); }
#undef IN
#undef SEAM
}

extern "C" void kernel_launch(void* const* d_in, const int* in_sizes, int n_in, void* d_out, int out_size, void* d_ws, size_t ws_size, hipStream_t stream) {
    static int grid = 0;
    if (grid == 0) {
        if (n_in != 19 || ws_size < WS_END) { fprintf(stderr, "kernel_launch: unexpected n_in %d / ws %zu\n", n_in, ws_size); grid = -1; return; }
        int dev = 0, cus = 0, per_cu = 0;
        if (hipGetDevice(&dev) != hipSuccess || hipDeviceGetAttribute(&cus, hipDeviceAttributeMultiprocessorCount, dev) != hipSuccess) { grid = -1; return; }
        if (hipFuncSetAttribute((const void*)fwd_mk, hipFuncAttributeMaxDynamicSharedMemorySize, LDS_BYTES) != hipSuccess) { fprintf(stderr, "kernel_launch: hipFuncSetAttribute failed\n"); grid = -1; return; }
        if (hipOccupancyMaxActiveBlocksPerMultiprocessor(&per_cu, (const void*)fwd_mk, NWAVES * 64, LDS_BYTES) != hipSuccess || per_cu < 1) fprintf(stderr, "kernel_launch: occupancy query says %d\n", per_cu);
        (void)hipGetLastError();
        grid = cus;
    }
    if (grid < 0) return;
    (void)hipMemsetAsync((char*)d_ws + WS_CTL, 0, CTL_ZERO_BYTES, stream);
    Args a{};
    for (int i = 0; i < 19; ++i) a.in[i] = (const float*)d_in[i];
    a.out = (float*)d_out; a.ws = (unsigned char*)d_ws;
#if MK_N_LAUNCHES == 1
    a.ph_lo = 0; a.ph_hi = NPH; a.li = 0;
    void* kargs[] = {&a};
    hipError_t e = hipLaunchCooperativeKernel((const void*)fwd_mk, dim3(grid), dim3(NWAVES * 64), kargs, LDS_BYTES, stream);
    if (e != hipSuccess) fprintf(stderr, "kernel_launch: cooperative launch failed: %s (grid %d)\n", hipGetErrorString(e), grid);
#else
    for (int li = 0; li < NPH; ++li) { a.ph_lo = li; a.ph_hi = li + 1; a.li = li; hipLaunchKernelGGL(fwd_mk, dim3(grid), dim3(NWAVES * 64), LDS_BYTES, stream, a); }
#endif
}
```

```cpp
#include <hip/hip_runtime.h>
#include <hip/hip_cooperative_groups.h>
#include <cstdio>
#include <cstdint>
#ifndef MK_N_LAUNCHES
#define MK_N_LAUNCHES 1
#endif
namespace pg8 {
#define PG8_LAS __attribute__((address_space(3)))
typedef unsigned short bf16_t;
typedef short bf16x8 __attribute__((ext_vector_type(8)));
typedef float f32x4 __attribute__((ext_vector_type(4)));
typedef unsigned u32x4 __attribute__((ext_vector_type(4)));
constexpr int BM = 256, BK = 64, HALF = 128, HTB = HALF * BK * 2  , STAGE_BYTES = 8 * HTB, NXCD = 8, WGM = 8;

__host__ __device__ __forceinline__ int lds_byte(int r, int c) { const int st = (r >> 4) * 2 + (c >> 5), rr = r & 15, cc = c & 31, ob = rr * 64 + cc * 2; return st * 1024 + (ob ^ (((ob >> 9) & 1) << 5)); }
__host__ __device__ __forceinline__ void stage_rc(int b, int& R, int& C) { const int st = b / 1024, sb = b % 1024, swz = sb ^ (((sb >> 9) & 1) << 5); R = (st >> 1) * 16 + swz / 64; C = (st & 1) * 32 + (swz % 64) / 2; }
__host__ __device__ __forceinline__ int perm32(int rho) { const int n = rho >> 4, i = rho & 15; return 8 * (i >> 2) + 4 * n + (i & 3); }

struct Unit { int pm, pn, half; };
struct Gemm { const bf16_t* A; const bf16_t* Bt; int M, N, K; };

struct StaticOrder {
    int nM, nN, nwg, G, c;
    __host__ __device__ void init(int M, int N, int G_, int c_) { nM = M / BM; nN = N / BM; nwg = nM * nN; G = G_; c = c_; }
    __host__ __device__ bool next(int i, Unit& u) const {
        const long L = (long)i * G + c; if (L >= nwg) return false;
        int wgid = (int)L; { const int q = nwg / NXCD, r = nwg % NXCD, xcd = wgid % NXCD, off = wgid / NXCD; wgid = (xcd < r ? xcd * (q + 1) : r * (q + 1) + (xcd - r) * q) + off; }
        const int nig = WGM * nN, gid = wgid / nig, fm = gid * WGM, gsz = (nM - fm) < WGM ? (nM - fm) : WGM;
        u.pm = fm + ((wgid % nig) % gsz); u.pn = (wgid % nig) / gsz; u.half = 0; return true;
    }
    __device__ __forceinline__ void a_ready(const Unit&) const {}
    __device__ __forceinline__ void done(const Unit&) const {}
};
struct TailSplitOrder {
    int nM, nN, nwg, G, c, nfull, nitems;
    __host__ __device__ void init(int M, int N, int G_, int c_) { nM = M / BM; nN = N / BM; nwg = nM * nN; G = G_; c = c_; nfull = (nwg / G) * G; const int rem = nwg - nfull;
        if (2 * rem > G) { nfull = nwg; } nitems = nfull + 2 * (nwg - nfull); }
    __host__ __device__ bool next(int i, Unit& u) const {
        const long L = (long)i * G + c; if (L >= nitems) return false;
        int wgid, half; if (L < nfull) { wgid = (int)L; half = 0; } else { wgid = nfull + (int)(L - nfull) / 2; half = 1 + (int)((L - nfull) & 1); }
        { const int q = nwg / NXCD, r = nwg % NXCD, xcd = wgid % NXCD, off = wgid / NXCD; wgid = (xcd < r ? xcd * (q + 1) : r * (q + 1) + (xcd - r) * q) + off; }
        const int nig = WGM * nN, gid = wgid / nig, fm = gid * WGM, gsz = (nM - fm) < WGM ? (nM - fm) : WGM;
        u.pm = fm + ((wgid % nig) % gsz); u.pn = (wgid % nig) / gsz; u.half = half; return true;
    }
    __device__ __forceinline__ void a_ready(const Unit&) const {}
    __device__ __forceinline__ void done(const Unit&) const {}
};
typedef float f32x2c __attribute__((ext_vector_type(2))); typedef __bf16 bf16x2c __attribute__((ext_vector_type(2)));
__device__ __forceinline__ unsigned cvt_pk_bf16(float lo, float hi) { const f32x2c v = {lo, hi}; const bf16x2c b = __builtin_convertvector(v, bf16x2c); return __builtin_bit_cast(unsigned, b); }
typedef float f32x2 __attribute__((ext_vector_type(2)));
typedef unsigned u32x2 __attribute__((ext_vector_type(2)));
__device__ __forceinline__ f32x4 silu_mul(f32x4 a, f32x4 b) {
    f32x4 o;
#pragma unroll
    for (int j = 0; j < 4; ++j) { const float e = __builtin_amdgcn_exp2f(a[j] * -1.4426950408889634f); o[j] = a[j] * b[j] * __builtin_amdgcn_rcpf(1.0f + e); }
    return o;
}
struct EpiSwiGLU {
    static constexpr bool PERM = false, AFTER_DRAIN = false;
    bf16_t* G; int ldg;
    __device__ __forceinline__ void operator()(const f32x4 (&acc)[2][2][4][2], const Unit& u, int wr, int wc, int fr, int fq) const {
        const int row0 = u.pm * BM + wr * 64 + fr, col0 = u.pn * HALF + wc * 32 + 8 * fq;
#pragma unroll
        for (int ai = 0; ai < 2; ++ai) { if (u.half && u.half != ai + 1) continue;
#pragma unroll
            for (int m = 0; m < 4; ++m) {
                const f32x4 g0 = silu_mul(acc[ai][0][m][0], acc[ai][1][m][0]), g1 = silu_mul(acc[ai][0][m][1], acc[ai][1][m][1]);
                u32x4 w; w.x = cvt_pk_bf16(g0[0], g0[1]); w.y = cvt_pk_bf16(g0[2], g0[3]); w.z = cvt_pk_bf16(g1[0], g1[1]); w.w = cvt_pk_bf16(g1[2], g1[3]);
                *(u32x4*)(G + (size_t)(row0 + ai * HALF + m * 16) * ldg + col0) = w; } }
    }
};
struct EpiY {
    static constexpr bool PERM = false, AFTER_DRAIN = false;
    bf16_t* C; int ldc;
    __device__ __forceinline__ void operator()(const f32x4 (&acc)[2][2][4][2], const Unit& u, int wr, int wc, int fr, int fq) const {
        const int row0 = u.pm * BM + wr * 64 + fr, col0 = u.pn * BM + wc * 32 + 8 * fq;
#pragma unroll
        for (int ai = 0; ai < 2; ++ai)
#pragma unroll
            for (int m = 0; m < 4; ++m) { bf16_t* rowp = C + (size_t)(row0 + ai * HALF + m * 16) * ldc + col0;
#pragma unroll
                for (int bj = 0; bj < 2; ++bj) { const f32x4 v0 = acc[ai][bj][m][0], v1 = acc[ai][bj][m][1];
                    u32x4 w; w.x = cvt_pk_bf16(v0[0], v0[1]); w.y = cvt_pk_bf16(v0[2], v0[3]); w.z = cvt_pk_bf16(v1[0], v1[1]); w.w = cvt_pk_bf16(v1[2], v1[3]); *(u32x4*)(rowp + bj * HALF) = w; } }
    }
};
struct EpiMix {
    static constexpr bool PERM = false, AFTER_DRAIN = false;
    bf16_t *Qb, *Kctx, *Klat, *Vtctx, *Vtlat, *BGb, *Zb; float *newk, *newv; const float *ropeC, *ropeS;
    __device__ __forceinline__ void operator()(const f32x4 (&acc)[2][2][4][2], const Unit& u, int wr, int wc, int fr, int fq) const {
        const int pn = u.pn, pm = u.pm; const bool lat = pm >= 32;
        const int lb = (pm - 32) >> 2, lt0 = ((pm - 32) & 3) * 256;
        const float C2 = 0.125f * 1.4426950408889634f;
        if (pn < 4) {
            const bool isk = pn >= 2; const int colbase = (pn & 1) * 256 + wc * 32 + 4 * fq;
#pragma unroll
            for (int ai = 0; ai < 2; ++ai)
#pragma unroll
                for (int m = 0; m < 4; ++m) {
                    const int rl = wr * 64 + fr + ai * HALF + m * 16, R = pm * BM + rl, t = lt0 + rl;
                    f32x4 c4 = {1.f, 1.f, 1.f, 1.f}, s4 = {0.f, 0.f, 0.f, 0.f};
                    if (lat) { const int pos = (wc & 1) ? (t & 63) : (t >> 6); c4 = *(const f32x4*)(ropeC + pos * 16 + 4 * fq); s4 = *(const f32x4*)(ropeS + pos * 16 + 4 * fq); }
                    bf16_t* dst = !isk ? Qb + (size_t)R * 512 : (lat ? Klat + (size_t)(lb * 1536 + 512 + t) * 512 : Kctx + (size_t)R * 512);
#pragma unroll
                    for (int bj = 0; bj < 2; ++bj) {
                        f32x4 x1 = acc[ai][bj][m][0], x2 = acc[ai][bj][m][1];
                        const int col = colbase + bj * HALF;
                        if (isk && !lat) { *(f32x4*)(newk + (size_t)R * 512 + col) = x1; *(f32x4*)(newk + (size_t)R * 512 + col + 16) = x2; }
                        const f32x4 y1 = x1 * c4 - x2 * s4, y2 = x2 * c4 + x1 * s4; x1 = y1; x2 = y2;
                        if (!isk) { x1 = x1 * C2; x2 = x2 * C2; }
                        u32x4 w; w.x = cvt_pk_bf16(x1[0], x1[1]); w.y = cvt_pk_bf16(x1[2], x1[3]); w.z = cvt_pk_bf16(x2[0], x2[1]); w.w = cvt_pk_bf16(x2[2], x2[3]);
                        *(u32x4*)(dst + (pn & 1) * 256 + bj * HALF + wc * 32 + 8 * fq) = w; } }
        } else if (pn < 6) {
            const int colbase = (pn - 4) * 256 + wc * 32 + 4 * fq;
#pragma unroll
            for (int ai = 0; ai < 2; ++ai)
#pragma unroll
                for (int m = 0; m < 4; ++m) {
                    const int rl = wr * 64 + fr + ai * HALF + m * 16, R = pm * BM + rl, t = lt0 + rl;
                    bf16_t* vt = lat ? Vtlat + (size_t)(lb * 512) * 1536 + 512 + t : Vtctx + (size_t)(pm * 512) * 256 + rl;
                    const size_t ldv = lat ? 1536 : 256;
#pragma unroll
                    for (int bj = 0; bj < 2; ++bj)
#pragma unroll
                        for (int n = 0; n < 2; ++n) { const f32x4 v = acc[ai][bj][m][n]; const int col = colbase + bj * HALF + n * 16;
                            if (!lat) *(f32x4*)(newv + (size_t)R * 512 + col) = v;
                            const unsigned p01 = cvt_pk_bf16(v[0], v[1]), p23 = cvt_pk_bf16(v[2], v[3]);
                            vt[(size_t)(col + 0) * ldv] = (bf16_t)(p01 & 0xffffu); vt[(size_t)(col + 1) * ldv] = (bf16_t)(p01 >> 16);
                            vt[(size_t)(col + 2) * ldv] = (bf16_t)(p23 & 0xffffu); vt[(size_t)(col + 3) * ldv] = (bf16_t)(p23 >> 16); } }
        } else if (pn < 8) {
            const int colbase = (pn - 6) * 256 + wc * 32 + 8 * fq;
#pragma unroll
            for (int ai = 0; ai < 2; ++ai)
#pragma unroll
                for (int m = 0; m < 4; ++m) { bf16_t* dst = BGb + (size_t)(pm * BM + wr * 64 + fr + ai * HALF + m * 16) * 512 + colbase;
#pragma unroll
                    for (int bj = 0; bj < 2; ++bj) { const f32x4 v0 = acc[ai][bj][m][0], v1 = acc[ai][bj][m][1];
                        u32x4 w; w.x = cvt_pk_bf16(v0[0], v0[1]); w.y = cvt_pk_bf16(v0[2], v0[3]); w.z = cvt_pk_bf16(v1[0], v1[1]); w.w = cvt_pk_bf16(v1[2], v1[3]); *(u32x4*)(dst + bj * HALF) = w; } }
        } else {
            const int col0 = (pn - 8) * HALF + wc * 32 + 8 * fq;
#pragma unroll
            for (int ai = 0; ai < 2; ++ai)
#pragma unroll
                for (int m = 0; m < 4; ++m) { const f32x4 z0 = acc[ai][0][m][0] * acc[ai][1][m][0], z1 = acc[ai][0][m][1] * acc[ai][1][m][1];
                    u32x4 w; w.x = cvt_pk_bf16(z0[0], z0[1]); w.y = cvt_pk_bf16(z0[2], z0[3]); w.z = cvt_pk_bf16(z1[0], z1[1]); w.w = cvt_pk_bf16(z1[2], z1[3]);
                    *(u32x4*)(Zb + (size_t)(pm * BM + wr * 64 + fr + ai * HALF + m * 16) * 512 + col0) = w; }
        }
    }
};
template <class Epi, class Sched, bool ALIGN_EPI = false, bool SP2 = false, bool HALFABLE = false>
__device__ __forceinline__ void gemm_phase(PG8_LAS unsigned char* lds, const Gemm g, const Sched& S, const Epi& E) {
    const int tid = threadIdx.x, wid = __builtin_amdgcn_readfirstlane(tid >> 6), lane = tid & 63, wr = wid >> 2, wc = wid & 3, fr = lane & 15, fq = lane >> 4;
    const int K = g.K, nt = K / BK;
    unsigned voffA[2], voffB[2];
#pragma unroll
    for (int i = 0; i < 2; ++i) { int R, C; stage_rc(tid * 16 + i * 8192, R, C); const int Rb = Epi::PERM ? ((R & ~31) + perm32(R & 31)) : R;
        voffA[i] = (unsigned)(R * K + C) * 2u; voffB[i] = (unsigned)(Rb * K + C) * 2u; }
    const size_t kstep = (size_t)(BK * 2);
    const size_t hstep = (size_t)HALF * K * 2;
    const size_t tstep = 2 * hstep;
    const unsigned ldsw = (unsigned)wid * 1024u;
    const int aoff = lds_byte(wr * 64 + fr, fq * 8), boff = lds_byte(wc * 32 + fr, fq * 8);
#define PG8_SA(b, h) (((b) * 2 + (h)) * HTB)
#define PG8_SB(b, h) ((4 + (b) * 2 + (h)) * HTB)
#define PG8_STAGE(bufoff, gbase, voff) do { _Pragma("unroll") for (int _i = 0; _i < 2; ++_i) \
        __builtin_amdgcn_global_load_lds((const unsigned*)((const char*)(gbase) + (voff)[_i]), (PG8_LAS unsigned*)(lds + (bufoff) + ldsw + _i * 8192), 16, 0, 0); } while (0)
#define PG8_LDA(dst, b, h) do { _Pragma("unroll") for (int m = 0; m < 4; ++m) _Pragma("unroll") for (int k = 0; k < 2; ++k) dst[m][k] = *(const PG8_LAS bf16x8*)(lds + PG8_SA(b, h) + aoff + m * 2048 + k * 1024); } while (0)
#define PG8_LDB(dst, b, h) do { _Pragma("unroll") for (int n = 0; n < 2; ++n) _Pragma("unroll") for (int k = 0; k < 2; ++k) dst[n][k] = *(const PG8_LAS bf16x8*)(lds + PG8_SB(b, h) + boff + n * 2048 + k * 1024); } while (0)
#define PG8_MMA(ai, bj, At, Bt) do { __builtin_amdgcn_s_setprio(1); _Pragma("unroll") for (int m = 0; m < 4; ++m) _Pragma("unroll") for (int n = 0; n < 2; ++n) _Pragma("unroll") for (int k = 0; k < 2; ++k) \
        acc[ai][bj][m][n] = __builtin_amdgcn_mfma_f32_16x16x32_bf16(Bt[n][k], At[m][k], acc[ai][bj][m][n], 0, 0, 0); __builtin_amdgcn_s_setprio(0); } while (0)
#define PG8_WAIT_V(n) asm volatile("s_waitcnt vmcnt(" #n ")" ::: "memory")
#define PG8_WAIT_L(n) asm volatile("s_waitcnt lgkmcnt(" #n ")" ::: "memory")
#define PG8_BAR __builtin_amdgcn_s_barrier()
#define PG8_SCHED __builtin_amdgcn_sched_barrier(0)
    Unit cur, nxt; int ui = 0;
    if (!S.next(0, cur)) return;
    f32x4 acc[2][2][4][2];
#pragma unroll
    for (int a = 0; a < 2; ++a)
#pragma unroll
        for (int b = 0; b < 2; ++b)
#pragma unroll
            for (int m = 0; m < 4; ++m)
#pragma unroll
                for (int n = 0; n < 2; ++n) acc[a][b][m][n] = (f32x4){0.f, 0.f, 0.f, 0.f};
    bf16x8 At[4][2], B0[2][2], B1[2][2];
    const char* cA = (const char*)g.A + (size_t)cur.pm * tstep; const char* cB = (const char*)g.Bt + (size_t)cur.pn * tstep;
    S.a_ready(cur);
    if constexpr (SP2) {
        PG8_STAGE(PG8_SB(0, 0), cB, voffB); PG8_STAGE(PG8_SB(0, 1), cB + hstep, voffB); PG8_STAGE(PG8_SA(0, 0), cA, voffA); PG8_STAGE(PG8_SA(0, 1), cA + hstep, voffA);
        if (wr == 1) PG8_BAR;
        PG8_WAIT_V(2); PG8_BAR;
        PG8_STAGE(PG8_SB(1, 0), cB + kstep, voffB); PG8_STAGE(PG8_SA(1, 0), cA + kstep, voffA); PG8_STAGE(PG8_SB(1, 1), cB + hstep + kstep, voffB);
        PG8_WAIT_V(6); PG8_BAR;
    } else {
        PG8_STAGE(PG8_SB(0, 0), cB, voffB); PG8_STAGE(PG8_SA(0, 0), cA, voffA); PG8_STAGE(PG8_SB(0, 1), cB + hstep, voffB); PG8_STAGE(PG8_SA(0, 1), cA + hstep, voffA);
        if (wr == 1) PG8_BAR;
        PG8_WAIT_V(4); PG8_BAR;
        PG8_STAGE(PG8_SB(1, 0), cB + kstep, voffB); PG8_STAGE(PG8_SA(1, 0), cA + kstep, voffA); PG8_STAGE(PG8_SB(1, 1), cB + hstep + kstep, voffB);
        PG8_WAIT_V(6); PG8_BAR;
    }
    for (;;) {
        const bool has_next = S.next(ui + 1, nxt);
        const bool do0 = !HALFABLE || cur.half != 2, do1 = !HALFABLE || cur.half != 1;
        const char* nA = has_next ? (const char*)g.A + (size_t)nxt.pm * tstep : cA; const char* nB = has_next ? (const char*)g.Bt + (size_t)nxt.pn * tstep : cB;
        for (int t = 0; t < nt; t += 2) {
            const bool last = (t == nt - 2);
            const char* a1 = cA + (size_t)(t + 1) * kstep;
            const char* a2 = last ? nA : cA + (size_t)(t + 2) * kstep; const char* b2 = last ? nB : cB + (size_t)(t + 2) * kstep;
            const char* a3 = a2 + kstep; const char* b3 = b2 + kstep;
            if (last && has_next) S.a_ready(nxt);
            if constexpr (SP2) {
            PG8_LDB(B0, 0, 0); PG8_LDB(B1, 0, 1); PG8_SCHED; if (do0) PG8_LDA(At, 0, 0); PG8_STAGE(PG8_SA(1, 1), a1 + hstep, voffA);
            PG8_WAIT_V(8); PG8_WAIT_L(0); PG8_BAR; if (do0) { PG8_MMA(0, 0, At, B0); PG8_MMA(0, 1, At, B1); } PG8_BAR; PG8_SCHED;
            if (do1) PG8_LDA(At, 0, 1); PG8_STAGE(PG8_SB(0, 0), b2, voffB); PG8_STAGE(PG8_SB(0, 1), b2 + hstep, voffB); PG8_STAGE(PG8_SA(0, 0), a2, voffA);
            PG8_WAIT_V(8); PG8_WAIT_L(0); PG8_BAR; if (do1) { PG8_MMA(1, 0, At, B0); PG8_MMA(1, 1, At, B1); } PG8_BAR; PG8_SCHED;
            PG8_LDB(B0, 1, 0); PG8_LDB(B1, 1, 1); PG8_SCHED; if (do0) PG8_LDA(At, 1, 0); PG8_STAGE(PG8_SA(0, 1), a2 + hstep, voffA);
            PG8_WAIT_V(8); PG8_WAIT_L(0); PG8_BAR; if (do0) { PG8_MMA(0, 0, At, B0); PG8_MMA(0, 1, At, B1); } PG8_BAR; PG8_SCHED;
            if (do1) PG8_LDA(At, 1, 1); PG8_STAGE(PG8_SB(1, 0), b3, voffB); PG8_STAGE(PG8_SB(1, 1), b3 + hstep, voffB); PG8_STAGE(PG8_SA(1, 0), a3, voffA);
            PG8_WAIT_V(8); PG8_WAIT_L(0); PG8_BAR; if (do1) { PG8_MMA(1, 0, At, B0); PG8_MMA(1, 1, At, B1); } PG8_BAR; PG8_SCHED;
            } else {
            PG8_LDB(B0, 0, 0); PG8_SCHED; PG8_LDA(At, 0, 0); PG8_STAGE(PG8_SA(1, 1), a1 + hstep, voffA);
            PG8_WAIT_L(8); PG8_BAR; PG8_WAIT_L(0); PG8_MMA(0, 0, At, B0); PG8_BAR; PG8_SCHED;
            PG8_LDB(B1, 0, 1); PG8_STAGE(PG8_SB(0, 0), b2, voffB);
            PG8_BAR; PG8_WAIT_L(0); PG8_MMA(0, 1, At, B1); PG8_BAR;
            PG8_LDA(At, 0, 1); PG8_STAGE(PG8_SA(0, 0), a2, voffA);
            PG8_BAR; PG8_WAIT_L(0); PG8_MMA(1, 0, At, B0); PG8_BAR; PG8_SCHED;
            PG8_STAGE(PG8_SB(0, 1), b2 + hstep, voffB);
            PG8_WAIT_V(6); PG8_BAR; PG8_MMA(1, 1, At, B1); PG8_BAR;
            PG8_LDB(B0, 1, 0); PG8_SCHED; PG8_LDA(At, 1, 0); PG8_STAGE(PG8_SA(0, 1), a2 + hstep, voffA);
            PG8_WAIT_L(8); PG8_BAR; PG8_WAIT_L(0); PG8_MMA(0, 0, At, B0); PG8_BAR; PG8_SCHED;
            PG8_LDB(B1, 1, 1); PG8_STAGE(PG8_SB(1, 0), b3, voffB);
            PG8_BAR; PG8_WAIT_L(0); PG8_MMA(0, 1, At, B1); PG8_BAR;
            PG8_LDA(At, 1, 1); PG8_STAGE(PG8_SA(1, 0), a3, voffA);
            PG8_BAR; PG8_WAIT_L(0); PG8_MMA(1, 0, At, B0); PG8_BAR; PG8_SCHED;
            PG8_STAGE(PG8_SB(1, 1), b3 + hstep, voffB);
            PG8_WAIT_V(6); PG8_BAR; PG8_MMA(1, 1, At, B1); PG8_BAR;
            }
        }
        if constexpr (ALIGN_EPI) { if (wr == 0) PG8_BAR; }
        if constexpr (!Epi::AFTER_DRAIN) { E(acc, cur, wr, wc, fr, fq); S.done(cur); }
        if (!has_next) break;
#pragma unroll
        for (int a = 0; a < 2; ++a)
#pragma unroll
            for (int b = 0; b < 2; ++b)
#pragma unroll
                for (int m = 0; m < 4; ++m)
#pragma unroll
                    for (int n = 0; n < 2; ++n) acc[a][b][m][n] = (f32x4){0.f, 0.f, 0.f, 0.f};
        cur = nxt; cA = nA; cB = nB; ++ui;
        if constexpr (ALIGN_EPI) { if (wr == 1) PG8_BAR; }
    }
    PG8_WAIT_V(0);
    if constexpr (!ALIGN_EPI) { if (wr == 0) PG8_BAR; }
    PG8_BAR;
    if constexpr (Epi::AFTER_DRAIN) { E.fused(acc, cur, wr, wc, fr, fq, lds, wid, lane); S.done(cur); }
#undef PG8_SA
#undef PG8_SB
#undef PG8_STAGE
#undef PG8_LDA
#undef PG8_LDB
#undef PG8_MMA
#undef PG8_WAIT_V
#undef PG8_WAIT_L
#undef PG8_BAR
#undef PG8_SCHED
}
}
constexpr int NWAVES = 8;
constexpr int D = 1024, MC = 8192, MLAT = 2048, M = MC + MLAT, FF = 2816, NUP = 2 * FF, NIN = 3072, AW = 512;
constexpr int TC = 256, TL = 1024, PAST = 512, TKL = PAST + TL, NMODC = 9 * D;
constexpr float EPS = 1e-6f;
constexpr size_t OUT_Y = 0, OUT_NK = (size_t)M * D, OUT_NV = OUT_NK + (size_t)MC * AW;
constexpr size_t MiB = 1u << 20, HMiB = 1u << 19;
constexpr size_t WS_CTL = 0, CTL_ZERO_BYTES = 64 * 1024;
constexpr size_t WS_MISC = 1 * MiB;
constexpr size_t WS_W1U = 2 * MiB, WS_W1D = 13 * MiB, WS_W2U = 13 * MiB + 11 * HMiB, WS_W2D = WS_W2U + 11 * MiB, WS_WIN = 35 * MiB, WS_WO = 41 * MiB;
constexpr size_t WS_KLAT = 43 * MiB, WS_VTLAT = 46 * MiB, WS_U = 49 * MiB, WS_Y = 69 * MiB, WS_X1 = 109 * MiB, WS_R = 149 * MiB;
constexpr size_t WS_G = WS_R, WS_QB = WS_R, WS_KCTX = WS_R + 10 * MiB, WS_VTCTX = WS_R + 18 * MiB, WS_BG = WS_R + 26 * MiB, WS_Z = WS_R + 36 * MiB, WS_MIX = WS_R + 46 * MiB;
constexpr size_t WS_END = WS_R + 66 * MiB;
static_assert(WS_W2D + 11 * HMiB == WS_WIN && WS_G + (size_t)M * FF * 2 <= WS_END && WS_END <= 256 * MiB, "ws map");
constexpr int CW_BAR = 1024;
constexpr int RING_BYTES = 131072, LDSCTL_OFF = RING_BYTES, MISC_OFF = LDSCTL_OFF + 320, LDS_BYTES = 147456;

#define GAS __attribute__((address_space(1)))
#define LAS __attribute__((address_space(3)))
typedef unsigned short bf16;
typedef unsigned v4u __attribute__((ext_vector_type(4)));
typedef unsigned v2u __attribute__((ext_vector_type(2)));
typedef float f32x4 __attribute__((ext_vector_type(4)));
typedef float f32x16 __attribute__((ext_vector_type(16)));
typedef short bf16x8 __attribute__((ext_vector_type(8)));
typedef short s16x4 __attribute__((ext_vector_type(4)));
#define LDS_WAIT() asm volatile("s_waitcnt lgkmcnt(0)" ::: "memory")
__device__ __forceinline__ unsigned f2bf(float f) { unsigned u = __builtin_bit_cast(unsigned, f); return (u + 0x7fffu + ((u >> 16) & 1u)) >> 16; }
typedef float f32x2_t __attribute__((ext_vector_type(2)));
typedef __bf16 bf16x2_t __attribute__((ext_vector_type(2)));
__device__ __forceinline__ unsigned pk2(float lo, float hi) { const f32x2_t v = {lo, hi}; const bf16x2_t b = __builtin_convertvector(v, bf16x2_t); return __builtin_bit_cast(unsigned, b); }
#define XB_TMO      128
#define XB_XCNT(j)  (256  + 64 * (j))
#define XB_XSUB(j)  (1280 + 64 * (j))
#define XB_XGEN(j)  (2304 + 64 * (j))
#define XB_TOP      3328
#define XB_TOPGEN   3392
#define XCD_BAR_WORDS 3456
#define XB_SPIN_CAP (1u << 18)

__device__ __forceinline__ unsigned xb_ld(unsigned* p)              { return __hip_atomic_load(p, __ATOMIC_RELAXED, __HIP_MEMORY_SCOPE_AGENT); }
__device__ __forceinline__ unsigned xb_add(unsigned* p, unsigned v) { return __hip_atomic_fetch_add(p, v, __ATOMIC_RELAXED, __HIP_MEMORY_SCOPE_AGENT); }
__device__ __forceinline__ unsigned xb_xcc_id() { return (unsigned)__builtin_amdgcn_s_getreg((3 << 11) | 20) & 0xFu; }
#define XB_SPIN(cond, bar) do { unsigned _sp = 0; while (cond) { __builtin_amdgcn_s_sleep(1); \
    if ((++_sp & 255u) == 0u) { if (xb_ld(&(bar)[XB_TMO])) break; if (_sp > XB_SPIN_CAP) { atomicAdd(&(bar)[XB_TMO], 1u); break; } } } } while (0)

struct XcdBarrier {
    unsigned* bar; unsigned x;
    volatile LAS unsigned* st;
};

__device__ __forceinline__ XcdBarrier xcd_barrier_post(unsigned* bar, volatile LAS unsigned* st) {
    XcdBarrier b; b.bar = bar; b.x = xb_xcc_id(); b.st = st;
    if (threadIdx.x == 0) (void)xb_add(&bar[XB_XCNT(b.x)], 1u);
    return b;
}
__device__ __forceinline__ void xcd_barrier_complete(unsigned* bar, unsigned x, unsigned& nloc, unsigned& nx) {
    const unsigned G = gridDim.x * gridDim.y * gridDim.z;
    unsigned sum, cnt, mine, sp = 0u;
    for (;;) {
        sum = 0u; cnt = 0u; mine = 0u;
#pragma unroll
        for (unsigned j = 0; j < 16; ++j) { const unsigned c = xb_ld(&bar[XB_XCNT(j)]); sum += c; cnt += (c > 0u) ? 1u : 0u; mine = (j == x) ? c : mine; }
        if (sum == G) break;
        __builtin_amdgcn_s_sleep(1);
        if ((++sp & 255u) == 0u) { if (xb_ld(&bar[XB_TMO])) break; if (sp > XB_SPIN_CAP) { atomicAdd(&bar[XB_TMO], 1u); break; } }
    }
    nloc = mine > 0u ? mine : 1u; nx = cnt > 0u ? cnt : 1u;
}

__device__ __forceinline__ void xcd_barrier(const XcdBarrier& b) {
    asm volatile("s_waitcnt vmcnt(0)" ::: "memory");
    __syncthreads();
    if (threadIdx.x == 0) {
        unsigned* bar = b.bar;
        __builtin_amdgcn_s_waitcnt(0);
        unsigned nloc = b.st[0], nx = b.st[1];
        if (nloc == 0u) { xcd_barrier_complete(bar, b.x, nloc, nx); b.st[0] = nloc; b.st[1] = nx; }
        const unsigned old = xb_add(&bar[XB_XSUB(b.x)], 1u);
        const unsigned gen = old / nloc;
        if (old + 1u == (gen + 1u) * nloc) {
            __builtin_amdgcn_fence(__ATOMIC_RELEASE, "agent");
            asm volatile("s_waitcnt vmcnt(0)" ::: "memory");
            const unsigned og = xb_add(&bar[XB_TOP], 1u);
            const unsigned tg = og / nx;
            if (og + 1u == (tg + 1u) * nx) {
                xb_add(&bar[XB_TOPGEN], 1u); xb_add(&bar[XB_XGEN(b.x)], 1u);
                __builtin_amdgcn_fence(__ATOMIC_ACQUIRE, "agent");
            } else {
                __builtin_amdgcn_fence(__ATOMIC_ACQUIRE, "agent");
                XB_SPIN(xb_ld(&bar[XB_TOPGEN]) == tg, bar);
                xb_add(&bar[XB_XGEN(b.x)], 1u);
            }
            asm volatile("s_waitcnt vmcnt(0)" ::: "memory");
        } else {
            __builtin_amdgcn_fence(__ATOMIC_ACQUIRE, "agent");
            XB_SPIN(xb_ld(&bar[XB_XGEN(b.x)]) == gen, bar);
            asm volatile("s_waitcnt vmcnt(0)" ::: "memory");
        }
    }
    __syncthreads();
}
struct Args { const float* in[19]; float* out; unsigned char* ws; int ph_lo, ph_hi, li, pad; };
struct Frame {
    LAS unsigned char* lds; int tid, lane, wave, G, bx;
};
__device__ __forceinline__ float wave_sum(float v) {
#pragma unroll
    for (int o = 1; o < 64; o <<= 1) v += __shfl_xor(v, o);
    return v;
}
__device__ __forceinline__ int slot5(int i) { return 16 * ((i >> 2) & 1) + 4 * (i >> 3) + (i & 3); }
__device__ __forceinline__ int dest_row(int mode, int c) {
    if (mode == 1) { const int hs = c >= FF ? 1 : 0, j = c - FF * hs; return 256 * (j >> 7) + 128 * hs + (j & 96) + slot5(j & 31); }
    if (mode == 2) { if (c < 1536) return c; if (c < 2048) return (c & ~31) + slot5(c & 31);     const int cc = c - 2048, hs = cc >> 9, j = cc & 511; return 2048 + 256 * (j >> 7) + 128 * hs + (j & 96) + slot5(j & 31); }
    if (mode == 3) return (c & ~31) + slot5(c & 31);
    return c;
}
__device__ __forceinline__ void tr_item(const float* W, int ldw, bf16* WT, size_t ldt, int k0, int n0, int mode, LAS float* scr, int lane) {
#pragma unroll 8
    for (int i = 0; i < 32; ++i) { const int kk = 2 * i + (lane >> 5); scr[kk * 33 + (lane & 31)] = W[(size_t)(k0 + kk) * ldw + n0 + (lane & 31)]; }
    LDS_WAIT(); asm volatile("" ::: "memory");
    const int c = lane & 7;
#pragma unroll
    for (int j = 0; j < 4; ++j) { const int n = (lane >> 3) + 8 * j; const LAS float* s = scr + (8 * c) * 33 + n;
        v4u o; o.x = pk2(s[0 * 33], s[1 * 33]); o.y = pk2(s[2 * 33], s[3 * 33]); o.z = pk2(s[4 * 33], s[5 * 33]); o.w = pk2(s[6 * 33], s[7 * 33]);
        *(v4u*)(WT + (size_t)dest_row(mode, n0 + n) * ldt + k0 + 8 * c) = o; }
    LDS_WAIT(); asm volatile("" ::: "memory");
}
__device__ __forceinline__ void p0_prologue(const Frame& F, const Args& a) {
    unsigned char* ws = a.ws;
    float* mod = (float*)(ws + WS_MISC);
    if (F.bx < NMODC / 64) {
        LAS float* sl = (LAS float*)F.lds;
        for (int i = F.tid; i < 3 * D; i += NWAVES * 64) { const int r = i >> 10, k = i & 1023; const float c = (r == 0) ? a.in[5][k] : a.in[2][(r - 1) * D + k]; sl[i] = c / (1.0f + __expf(-c)); }
        __syncthreads();
        for (int it = F.bx; it < NMODC / 64; it += F.G) {
            const float* w = a.in[6] + (size_t)(128 * F.wave) * NMODC + it * 64 + F.lane;
            float a0 = 0.f, a1 = 0.f, a2 = 0.f;
#pragma unroll 16
            for (int k = 0; k < 128; ++k) { const float wv = w[(size_t)k * NMODC]; const int kk = 128 * F.wave + k; a0 += sl[kk] * wv; a1 += sl[D + kk] * wv; a2 += sl[2 * D + kk] * wv; }
            LAS float* red = (LAS float*)(F.lds + 16384);
            red[(F.wave * 3 + 0) * 64 + F.lane] = a0; red[(F.wave * 3 + 1) * 64 + F.lane] = a1; red[(F.wave * 3 + 2) * 64 + F.lane] = a2;
            __syncthreads();
            if (F.tid < 192) { const int r = F.tid >> 6, l = F.tid & 63; float s = a.in[7][it * 64 + l];
#pragma unroll
                for (int w8 = 0; w8 < 8; ++w8) s += red[(w8 * 3 + r) * 64 + l];
                mod[r * NMODC + it * 64 + l] = s; }
            __syncthreads();
        }
    }
    if (F.bx == F.G - 1) {
        float* rc = (float*)(ws + WS_MISC + 128 * 1024); float* rs = rc + 1024;
        for (int i = F.tid; i < 1024; i += NWAVES * 64) { const int pos = i >> 4, f = i & 15; const float fr = powf(10000.0f, -(float)(2 * f) / 32.0f); float sn, cs; sincosf((float)pos * fr, &sn, &cs); rc[i] = cs; rs[i] = sn; }
    }
    __syncthreads();
    LAS float* scr = (LAS float*)(F.lds + F.wave * 16384);
    const int gw = F.bx * NWAVES + F.wave, NGW = F.G * NWAVES;
    constexpr int I_UP = (D / 64) * (NUP / 32);
    const int h0 = (F.G >= 2 * (NMODC / 64) - 32) ? NMODC / 64 : 0;
    if (F.bx >= h0) for (int r = (F.bx - h0) * NWAVES + F.wave; r < I_UP; r += (F.G - h0) * NWAVES) tr_item(a.in[10], NUP, (bf16*)(ws + WS_W1U), D, 64 * (r / (NUP / 32)), 32 * (r % (NUP / 32)), 1, scr, F.lane);
}
__device__ __forceinline__ void deferred_items(const Frame& F, const Args& a, int set, int hw, int NHW) {
    unsigned char* ws = a.ws;
    LAS float* scr = (LAS float*)(F.lds + F.wave * 16384);
    constexpr int I_UP = (D / 64) * (NUP / 32), I_DN = (FF / 64) * (D / 32), I_IN = (D / 64) * (NIN / 32), I_O = (D / 64) * (D / 32), I_CV = (PAST / 64) * (AW / 32);
    if (set == 0) { for (int r = hw; r < I_DN; r += NHW) tr_item(a.in[11], D, (bf16*)(ws + WS_W1D), FF, 64 * (r / (D / 32)), 32 * (r % (D / 32)), 3, scr, F.lane); return; }
    constexpr int NITEMS = I_UP + I_DN + I_IN + I_O + 2 * I_CV;
    for (int it = hw; it < NITEMS; it += NHW) {
        int r = it;
        if (r < I_UP) { tr_item(a.in[12], NUP, (bf16*)(ws + WS_W2U), D, 64 * (r / (NUP / 32)), 32 * (r % (NUP / 32)), 1, scr, F.lane); continue; } r -= I_UP;
        if (r < I_DN) { tr_item(a.in[13], D, (bf16*)(ws + WS_W2D), FF, 64 * (r / (D / 32)), 32 * (r % (D / 32)), 3, scr, F.lane); continue; } r -= I_DN;
        if (r < I_IN) { tr_item(a.in[14], NIN, (bf16*)(ws + WS_WIN), D, 64 * (r / (NIN / 32)), 32 * (r % (NIN / 32)), 2, scr, F.lane); continue; } r -= I_IN;
        if (r < I_O) { tr_item(a.in[18], D, (bf16*)(ws + WS_WO), D, 64 * (r / (D / 32)), 32 * (r % (D / 32)), 3, scr, F.lane); continue; } r -= I_O;
        { const int b = r / I_CV; r -= b * I_CV;
          tr_item(a.in[4] + (size_t)b * PAST * AW, AW, (bf16*)(ws + WS_VTLAT) + (size_t)b * AW * TKL, TKL, 64 * (r / (AW / 32)), 32 * (r % (AW / 32)), 0, scr, F.lane); }
    }
    for (int i = hw * 64 + F.lane; i < 2 * PAST * AW / 4; i += NHW * 64) {
        const int e = i * 4, b = e / (PAST * AW), rem = e - b * (PAST * AW);
        const f32x4 v = *(const f32x4*)(a.in[3] + e); v2u o; o.x = pk2(v[0], v[1]); o.y = pk2(v[2], v[3]);
        const int d = rem & 31, remp = (rem & ~31) + 8 * ((d >> 2) & 3) + 4 * (d >> 4);
        *(v2u*)((bf16*)(ws + WS_KLAT) + (size_t)b * TKL * AW + remp) = o; }
}
__device__ __forceinline__ const float* xrow_in(const Args& a, int m) { return m < MC ? a.in[0] + (size_t)m * D : a.in[1] + (size_t)(m - MC) * D; }
__device__ __forceinline__ int modrow(int m) { return m < MC ? 0 : 1 + ((m - MC) >> 10); }
__device__ __forceinline__ void norm_mod_store(const f32x4 (&x)[4], const float* g, const float* sh, const float* sc, bf16* urow, int lane) {
    float ss = 0.f;
#pragma unroll
    for (int j = 0; j < 4; ++j) ss += (x[j][0] * x[j][0] + x[j][1] * x[j][1]) + (x[j][2] * x[j][2] + x[j][3] * x[j][3]);
    const float rstd = 1.0f / sqrtf(wave_sum(ss) * (1.0f / D) + EPS);
#pragma unroll
    for (int j = 0; j < 4; ++j) { const int c = 4 * (lane + 64 * j); const f32x4 gv = *(const f32x4*)(g + c), sv = *(const f32x4*)(sh + c), cv = *(const f32x4*)(sc + c);
        const f32x4 u = x[j] * rstd * gv * (cv + 1.0f) + sv; v2u o; o.x = pk2(u[0], u[1]); o.y = pk2(u[2], u[3]); *(v2u*)(urow + c) = o; }
}
__device__ __forceinline__ void row_phase(const Frame& F, const Args& a, int sub) {
    unsigned char* ws = a.ws; const float* mod = (const float*)(ws + WS_MISC);
    const bf16* Y = (const bf16*)(ws + WS_Y); bf16* X1 = (bf16*)(ws + WS_X1); bf16* U = (bf16*)(ws + WS_U);
    const int gw = F.bx * NWAVES + F.wave, NGW = F.G * NWAVES, lane = F.lane;
    int rcur = -1; f32x4 A[4], B[4], C[4];
    for (int m = gw; m < M; m += NGW) {
        const int r = modrow(m);
        if (r != rcur) { rcur = r; const float* mr = mod + r * NMODC;
#pragma unroll
            for (int j = 0; j < 4; ++j) { const int c = 4 * (lane + 64 * j);
                if (sub >= 1) { const int i = sub - 1; const float gs = (i == 1) ? 1.0f : 0.5f; A[j] = (*(const f32x4*)(mr + (i * 3 + 2) * D + c) * gs) * *(const f32x4*)(a.in[9] + i * D + c); }
                if (sub <= 2) { B[j] = *(const f32x4*)(a.in[8] + sub * D + c) * (*(const f32x4*)(mr + (sub * 3 + 1) * D + c) + 1.0f); C[j] = *(const f32x4*)(mr + (sub * 3 + 0) * D + c); } } }
        f32x4 x[4];
        if (sub <= 1) { const float* xp = xrow_in(a, m);
#pragma unroll
            for (int j = 0; j < 4; ++j) x[j] = *(const f32x4*)(xp + 4 * (lane + 64 * j));
        } else {
#pragma unroll
            for (int j = 0; j < 4; ++j) { const v2u xw = *(const v2u*)(X1 + (size_t)m * D + 4 * (lane + 64 * j)); x[j] = (f32x4){__uint_as_float(xw.x << 16), __uint_as_float(xw.x & 0xffff0000u), __uint_as_float(xw.y << 16), __uint_as_float(xw.y & 0xffff0000u)}; }
        }
        if (sub >= 1) {
            f32x4 y[4]; float ss = 0.f;
#pragma unroll
            for (int j = 0; j < 4; ++j) { const v2u yw = *(const v2u*)(Y + (size_t)m * D + 4 * (lane + 64 * j)); y[j] = (f32x4){__uint_as_float(yw.x << 16), __uint_as_float(yw.x & 0xffff0000u), __uint_as_float(yw.y << 16), __uint_as_float(yw.y & 0xffff0000u)}; ss += (y[j][0] * y[j][0] + y[j][1] * y[j][1]) + (y[j][2] * y[j][2] + y[j][3] * y[j][3]); }
            const float rstd = 1.0f / sqrtf(wave_sum(ss) * (1.0f / D) + EPS);
#pragma unroll
            for (int j = 0; j < 4; ++j) { const int c = 4 * (lane + 64 * j);
                x[j] = x[j] + A[j] * (y[j] * rstd);
                if (sub == 3) *(f32x4*)(a.out + OUT_Y + (size_t)m * D + c) = x[j];
                else { v2u o; o.x = pk2(x[j][0], x[j][1]); o.y = pk2(x[j][2], x[j][3]); *(v2u*)(X1 + (size_t)m * D + c) = o; } }
        }
        if (sub <= 2) {
            float ss = 0.f;
#pragma unroll
            for (int j = 0; j < 4; ++j) ss += (x[j][0] * x[j][0] + x[j][1] * x[j][1]) + (x[j][2] * x[j][2] + x[j][3] * x[j][3]);
            const float rstd = 1.0f / sqrtf(wave_sum(ss) * (1.0f / D) + EPS);
#pragma unroll
            for (int j = 0; j < 4; ++j) { const int c = 4 * (lane + 64 * j); const f32x4 u = (x[j] * rstd) * B[j] + C[j]; v2u o; o.x = pk2(u[0], u[1]); o.y = pk2(u[2], u[3]); *(v2u*)(U + (size_t)m * D + c) = o; }
        }
    }
}
__device__ __forceinline__ float max3f(float a, float b, float c) { float r; asm("v_max3_f32 %0, %1, %2, %3" : "=v"(r) : "v"(a), "v"(b), "v"(c)); return r; }
constexpr int AT_STG = 32768;
static_assert(4 * AT_STG <= RING_BYTES && 4 * 16896 <= RING_BYTES, "attention LDS");
#define AT_WAIT_V(n) asm volatile("s_waitcnt vmcnt(" #n ")" ::: "memory")
template <bool LAT, int VAR = 0>
__device__ __forceinline__ void attn_unit(const Frame& F, const bf16* Qb, const bf16* Kp, const bf16* Vt, int ldv, int T, int qrow0, int h, float lam, const float* subg, bf16* MIX) {
    const int tid = F.tid, lane = F.lane, wid = F.wave, r = lane & 31, hh = lane >> 5, map = wid & 1;
    const int kvh = LAT ? ((wid >> 1) & 1) : 0, qb = LAT ? (wid >> 2) : (wid >> 1);
    const int qrow = qrow0 + 32 * qb + r;
    const bf16* qp = Qb + (size_t)qrow * AW + h * 128 + map * 64 + 8 * hh;
    bf16x8 qf[4];
#pragma unroll
    for (int kk = 0; kk < 4; ++kk) qf[kk] = *(const bf16x8*)(qp + 16 * kk);
    asm volatile("" : "+v"(qf[0]), "+v"(qf[1]), "+v"(qf[2]), "+v"(qf[3]));
    unsigned kgo[2], vgo[2];
#pragma unroll
    for (int i = 0; i < 2; ++i) { const int q = i * 512 + tid;
        { const int key = q >> 4, part = (q & 15) ^ (key & 15); kgo[i] = (unsigned)(key * AW + h * 128 + part * 8); }
        { const int e = q >> 3, part = (q & 7) ^ ((e >> 1) & 7); vgo[i] = (unsigned)((h * 128 + e) * ldv + part * 8); } }
    const unsigned ldsw = (unsigned)wid * 1024u;
#define AT_GLDS_K(s, slot, i_) __builtin_amdgcn_global_load_lds((const unsigned*)(Kp + (size_t)(s) * 64 * AW + kgo[i_]), (LAS unsigned*)(F.lds + (slot) * AT_STG + (i_) * 8192 + ldsw), 16, 0, 0)
#define AT_GLDS_V(s, slot, i_) __builtin_amdgcn_global_load_lds((const unsigned*)(Vt + (s) * 64 + vgo[i_]), (LAS unsigned*)(F.lds + (slot) * AT_STG + 16384 + (i_) * 8192 + ldsw), 16, 0, 0)
#define AT_STAGE(s, slot) do { AT_GLDS_K(s, slot, 0); AT_GLDS_V(s, slot, 0); AT_GLDS_K(s, slot, 1); AT_GLDS_V(s, slot, 1); } while (0)
#define AT_PIN() __builtin_amdgcn_sched_barrier(0)
    const int rp = (r & 19) | ((r & 4) << 1) | ((r & 8) >> 1);
    int kread[4], vread[2];
#pragma unroll
    for (int kk = 0; kk < 4; ++kk) kread[kk] = rp * 256 + (((map * 8 + 2 * kk + hh) ^ (rp & 15)) * 16);
#pragma unroll
    for (int s2 = 0; s2 < 2; ++s2) vread[s2] = 16384 + r * 128 + (((2 * s2 + hh) ^ ((r >> 1) & 7)) * 16);
    f32x16 acc[4];
#pragma unroll
    for (int et = 0; et < 4; ++et)
#pragma unroll
        for (int i = 0; i < 16; ++i) acc[et][i] = 0.f;
    float mrun = -INFINITY, lrun = 0.f;
    __builtin_amdgcn_s_barrier();
    __builtin_amdgcn_sched_barrier(0);
    if (VAR != 1) { AT_STAGE(0, 0); AT_STAGE((T > 1 ? 1 : T - 1), 1); AT_STAGE((T > 2 ? 2 : T - 1), 2); }
    for (int t = 0; t < T; ++t) {
        if (VAR != 1) AT_WAIT_V(8);
        __builtin_amdgcn_s_barrier();
        __builtin_amdgcn_sched_barrier(0);
        const int sn = (t + 3 < T) ? t + 3 : T - 1, sl = (t + 3) & 3;
        const LAS unsigned char* buf = F.lds + (t & 3) * AT_STG;
        if (VAR == 2) AT_STAGE(sn, sl);
#pragma unroll
        for (int jj = 0; jj < (VAR == 2 ? 0 : (LAT ? 1 : 2)); ++jj) {
            const int j = LAT ? kvh : jj;
            bf16x8 kf[4];
#pragma unroll
            for (int kk = 0; kk < 4; ++kk) kf[kk] = *(const LAS bf16x8*)(buf + kread[kk] + j * 32 * 256);
            f32x16 s;
#pragma unroll
            for (int i = 0; i < 16; ++i) s[i] = 0.f;
#pragma unroll
            for (int kk = 0; kk < 4; ++kk) s = __builtin_amdgcn_mfma_f32_32x32x16_bf16(kf[kk], qf[kk], s, 0, 0, 0);
            if (VAR != 1) { AT_PIN(); if (LAT) { AT_GLDS_K(sn, sl, 0); AT_GLDS_V(sn, sl, 0); } else if (jj == 0) AT_GLDS_K(sn, sl, 0); else AT_GLDS_K(sn, sl, 1); AT_PIN(); }
            bf16x8 vf[4][2];
#pragma unroll
            for (int et = 0; et < 4; ++et)
#pragma unroll
                for (int s2 = 0; s2 < 2; ++s2) vf[et][s2] = *(const LAS bf16x8*)(buf + (vread[s2] ^ (j * 64)) + et * 32 * 128);
            float mx = fmaxf(fmaxf(fmaxf(s[0], s[1]), fmaxf(s[2], s[3])), fmaxf(fmaxf(s[4], s[5]), fmaxf(s[6], s[7])));
            mx = fmaxf(mx, fmaxf(fmaxf(fmaxf(s[8], s[9]), fmaxf(s[10], s[11])), fmaxf(fmaxf(s[12], s[13]), fmaxf(s[14], s[15]))));
            mx = fmaxf(mx, mrun);
            const float mnew = fmaxf(mx, __shfl_xor(mx, 32));
            if (__builtin_amdgcn_ballot_w64(mnew > mrun + 8.0f) != 0ull) {
                const float alpha = __builtin_amdgcn_exp2f(mrun - mnew);
                lrun *= alpha;
#pragma unroll
                for (int et = 0; et < 4; ++et) acc[et] = acc[et] * alpha;
                mrun = mnew; }
            float ps = 0.f;
#pragma unroll
            for (int i = 0; i < 16; ++i) { s[i] = __builtin_amdgcn_exp2f(s[i] - mrun); ps += s[i]; }
            lrun += ps;
            bf16x8 pf[2];
#pragma unroll
            for (int s2 = 0; s2 < 2; ++s2) { v4u w; w.x = pk2(s[8 * s2 + 0], s[8 * s2 + 1]); w.y = pk2(s[8 * s2 + 2], s[8 * s2 + 3]); w.z = pk2(s[8 * s2 + 4], s[8 * s2 + 5]); w.w = pk2(s[8 * s2 + 6], s[8 * s2 + 7]); pf[s2] = __builtin_bit_cast(bf16x8, w); }
            if (VAR != 1) { AT_PIN(); if (LAT) { AT_GLDS_K(sn, sl, 1); AT_GLDS_V(sn, sl, 1); } else if (jj == 0) AT_GLDS_V(sn, sl, 0); else AT_GLDS_V(sn, sl, 1); AT_PIN(); }
#pragma unroll
            for (int et = 0; et < 4; ++et)
#pragma unroll
                for (int s2 = 0; s2 < 2; ++s2) acc[et] = __builtin_amdgcn_mfma_f32_32x32x16_bf16(vf[et][s2], pf[s2], acc[et], 0, 0, 0);
        }
    }
    AT_WAIT_V(0);
    __syncthreads();
    if (LAT) {
        LAS float* mb = (LAS float*)(F.lds + (qb * 2 + map) * 16896);
        if (kvh) {
#pragma unroll
            for (int et = 0; et < 4; ++et)
#pragma unroll
                for (int i = 0; i < 16; ++i) mb[(et * 16 + i) * 64 + lane] = acc[et][i];
            mb[4096 + lane] = mrun; mb[4160 + lane] = lrun; }
        __syncthreads();
        if (!kvh) { const float m1 = mb[4096 + lane], l1 = mb[4160 + lane], mt = fmaxf(mrun, m1), a0 = __builtin_amdgcn_exp2f(mrun - mt), a1 = __builtin_amdgcn_exp2f(m1 - mt);
            lrun = lrun * a0 + l1 * a1;
#pragma unroll
            for (int et = 0; et < 4; ++et)
#pragma unroll
                for (int i = 0; i < 16; ++i) acc[et][i] = acc[et][i] * a0 + mb[(et * 16 + i) * 64 + lane] * a1; }
        __syncthreads();
    }
    const float ltot = lrun + __shfl_xor(lrun, 32);
    const float inv = (map ? lam : 1.0f) / ltot;
    LAS float* xb = (LAS float*)(F.lds + qb * 16384);
    if (map && !kvh) {
#pragma unroll
        for (int et = 0; et < 4; ++et)
#pragma unroll
            for (int i = 0; i < 16; ++i) xb[(et * 16 + i) * 64 + lane] = acc[et][i] * inv;
    }
    __syncthreads();
    if (!map && !kvh) {
        f32x4 gv[4][4];
#pragma unroll
        for (int et = 0; et < 4; ++et)
#pragma unroll
            for (int g = 0; g < 4; ++g) gv[et][g] = *(const f32x4*)(subg + 32 * et + 8 * g + 4 * hh);
        float ss = 0.f;
#pragma unroll
        for (int et = 0; et < 4; ++et)
#pragma unroll
            for (int i = 0; i < 16; ++i) { const float o = acc[et][i] * inv - xb[(et * 16 + i) * 64 + lane]; acc[et][i] = o; ss += o * o; }
        ss += __shfl_xor(ss, 32);
        const float rstd = 0.8f / sqrtf(ss * (1.0f / 128.0f) + EPS);
        bf16* op = MIX + (size_t)qrow * D + h * 128 + 4 * hh;
#pragma unroll
        for (int et = 0; et < 4; ++et)
#pragma unroll
            for (int g = 0; g < 4; ++g) { const int e = 32 * et + 8 * g;
                v2u w; w.x = pk2(acc[et][4 * g + 0] * rstd * gv[et][g][0], acc[et][4 * g + 1] * rstd * gv[et][g][1]); w.y = pk2(acc[et][4 * g + 2] * rstd * gv[et][g][2], acc[et][4 * g + 3] * rstd * gv[et][g][3]);
                *(v2u*)(op + e) = w; }
    }
    asm volatile("s_waitcnt vmcnt(0)" ::: "memory");
#undef AT_STAGE
#undef AT_GLDS_K
#undef AT_GLDS_V
#undef AT_PIN
}
__device__ __forceinline__ void attn_conv_phase(const Frame& F, const Args& a, int parts) {
    unsigned char* ws = a.ws;
    const bf16* Qb = (const bf16*)(ws + WS_QB); const bf16* Kctx = (const bf16*)(ws + WS_KCTX); const bf16* Klat = (const bf16*)(ws + WS_KLAT);
    const bf16* Vtctx = (const bf16*)(ws + WS_VTCTX); const bf16* Vtlat = (const bf16*)(ws + WS_VTLAT); bf16* MIX = (bf16*)(ws + WS_MIX);
    const float* lq = a.in[16];
    const float d01 = wave_sum(lq[F.lane] * lq[64 + F.lane]), d23 = wave_sum(lq[128 + F.lane] * lq[192 + F.lane]);
    const float lam = expf(d01) - expf(d23) + 0.2f;
    const int NU = 128 + 256;
    int u = F.bx, ustep = F.G;
    if (F.G == 256 && F.bx >= 128) ustep = 128;
    for (; u < NU; u += ustep) {
        if (F.G == 256 && F.bx < 128 && u >= 128) break;
        if (u < 128 ? !(parts & 1) : !(parts & 2)) continue;
        if (u < 128) { const int bh = u & 7, b = bh >> 2, h = bh & 3, qk = u >> 3;
            if (parts & 8) attn_unit<true, 1>(F, Qb, Klat + (size_t)b * TKL * AW, Vtlat + (size_t)b * AW * TKL, TKL, TKL / 64, MC + b * TL + qk * 64, h, lam, a.in[17], (bf16*)(ws + 216 * MiB));
            else if (parts & 16) attn_unit<true, 2>(F, Qb, Klat + (size_t)b * TKL * AW, Vtlat + (size_t)b * AW * TKL, TKL, TKL / 64, MC + b * TL + qk * 64, h, lam, a.in[17], (bf16*)(ws + 216 * MiB));
            else attn_unit<true>(F, Qb, Klat + (size_t)b * TKL * AW, Vtlat + (size_t)b * AW * TKL, TKL, TKL / 64, MC + b * TL + qk * 64, h, lam, a.in[17], MIX);
        } else { const int uc = u - 128, bh = uc >> 1, b = bh >> 2, h = bh & 3, qk = uc & 1;
            attn_unit<false>(F, Qb, Kctx + (size_t)b * TC * AW, Vtctx + (size_t)b * AW * TC, TC, TC / 64, b * TC + qk * 128, h, lam, a.in[17], MIX); }
    }
    __syncthreads();
    {
        const bf16* BGb = (const bf16*)(ws + WS_BG); const bf16* Zb = (const bf16*)(ws + WS_Z); const float* cw = a.in[15];
        const int t0 = F.bx * NWAVES * 64 + F.tid, tstep = F.G * NWAVES * 64, c = (F.tid & 63) * 8;
        float w0[8], w1[8], w2[8];
#pragma unroll
        for (int j = 0; j < 8; ++j) { w0[j] = cw[c + j]; w1[j] = cw[AW + c + j]; w2[j] = cw[2 * AW + c + j]; }
        constexpr int CB = 5, NRB = M / CB;
        for (int i = (parts & 4) ? t0 : NRB * 64; i < NRB * 64; i += tstep) {
            const int m0 = (i >> 6) * CB;
            v4u z[CB + 2], bgv[CB];
#pragma unroll
            for (int k = 0; k < CB + 2; ++k) { int mm = m0 - 1 + k; mm = mm < 0 ? 0 : (mm > M - 1 ? M - 1 : mm); z[k] = *(const v4u*)(Zb + (size_t)mm * AW + c); }
#pragma unroll
            for (int k = 0; k < CB; ++k) bgv[k] = *(const v4u*)(BGb + (size_t)(m0 + k) * AW + c);
#pragma unroll
            for (int k = 0; k < CB; ++k) { const int m = m0 + k;
                const int tl = m < MC ? (m & 255) : ((m - MC) & 1023), T = m < MC ? TC : TL;
                const bool hp = tl > 0, hn = tl < T - 1;
                float o[8];
#pragma unroll
                for (int j = 0; j < 8; ++j) {
                    const unsigned sh = (j & 1) * 16;
                    const float fp = hp ? __uint_as_float(((z[k][j >> 1] >> sh) & 0xffffu) << 16) : 0.f, fc = __uint_as_float(((z[k + 1][j >> 1] >> sh) & 0xffffu) << 16), fn = hn ? __uint_as_float(((z[k + 2][j >> 1] >> sh) & 0xffffu) << 16) : 0.f;
                    const float fb = __uint_as_float(((bgv[k][j >> 1] >> sh) & 0xffffu) << 16);
                    o[j] = fb * (w0[j] * fp + w1[j] * fc + w2[j] * fn); }
                v4u w; w.x = pk2(o[0], o[1]); w.y = pk2(o[2], o[3]); w.z = pk2(o[4], o[5]); w.w = pk2(o[6], o[7]);
                *(v4u*)(MIX + (size_t)m * D + AW + c) = w; }
        }
    }
}
constexpr int NPH = 12;
__global__ void __launch_bounds__(NWAVES * 64, 2) fwd_mk(Args args) {
    extern __shared__ __attribute__((aligned(16))) unsigned char lds[];
    Frame F; F.lds = (LAS unsigned char*)lds; F.tid = threadIdx.x; F.lane = F.tid & 63; F.wave = __builtin_amdgcn_readfirstlane(F.tid >> 6); F.G = gridDim.x; F.bx = blockIdx.x;
    unsigned char* ws = args.ws;
    for (int u = F.tid; u < (LDS_BYTES - LDSCTL_OFF) / 4; u += NWAVES * 64) ((LAS unsigned*)(F.lds + LDSCTL_OFF))[u] = 0u;
    __syncthreads();
    XcdBarrier bar; bar.bar = (unsigned*)(ws + WS_CTL) + CW_BAR; bar.x = 0; bar.st = nullptr;
    if (MK_N_LAUNCHES == 1) bar = xcd_barrier_post((unsigned*)(ws + WS_CTL) + CW_BAR, (volatile LAS unsigned*)(F.lds + MISC_OFF) + 8);
    const int lo = args.ph_lo, hi = args.ph_hi;
#define IN(k) (lo <= (k) && (k) < hi)
#define SEAM(k) do { if (IN(k) && IN((k) + 1)) xcd_barrier(bar); } while (0)
#ifndef PROBE_PARTS
#define PROBE_PARTS 7
#endif
#ifndef PROBE_DUP
#define PROBE_DUP -1
#endif
#define REP(k) for (int rep_ = 0; rep_ < ((k) == PROBE_DUP ? 2 : 1); ++rep_, ((k) == PROBE_DUP && rep_ == 1 ? xcd_barrier(bar) : (void)0))
    bf16* U = (bf16*)(ws + WS_U); bf16* Gb = (bf16*)(ws + WS_G); bf16* Y = (bf16*)(ws + WS_Y);
    if (IN(0)) REP(0) { p0_prologue(F, args); } SEAM(0);
    if (IN(1)) REP(1) { row_phase(F, args, 0); } SEAM(1);
    if (IN(2)) REP(2) { pg8::Gemm g{U, (const bf16*)(ws + WS_W1U), M, NUP, D}; pg8::StaticOrder S; S.init(M, NUP, F.G, F.bx); pg8::EpiSwiGLU E{Gb, FF};
        pg8::gemm_phase<pg8::EpiSwiGLU, pg8::StaticOrder, true, true>(F.lds, g, S, E);
        { const int nwg = (M / 256) * (NUP / 256), c0 = nwg % F.G, h0 = (nwg > F.G) ? c0 : 0;
          if (F.bx >= h0) deferred_items(F, args, 0, (F.bx - h0) * NWAVES + F.wave, (F.G - h0) * NWAVES); } } SEAM(2);
    if (IN(3)) REP(3) { pg8::Gemm g{Gb, (const bf16*)(ws + WS_W1D), M, D, FF}; pg8::StaticOrder S; S.init(M, D, F.G, F.bx); pg8::EpiY E{Y, D};
        pg8::gemm_phase<pg8::EpiY, pg8::StaticOrder, true, true>(F.lds, g, S, E);
        { const int nwg = (M / 256) * (D / 256), h0 = F.G > nwg ? nwg : 0;
          if (F.bx >= h0) deferred_items(F, args, 1, (F.bx - h0) * NWAVES + F.wave, (F.G - h0) * NWAVES); } } SEAM(3);
    if (IN(4)) REP(4) { row_phase(F, args, 1); } SEAM(4);
    if (IN(5)) REP(5) { pg8::Gemm g{U, (const bf16*)(ws + WS_WIN), M, NIN, D}; pg8::StaticOrder S; S.init(M, NIN, F.G, F.bx);
        pg8::EpiMix E{(bf16*)(ws + WS_QB), (bf16*)(ws + WS_KCTX), (bf16*)(ws + WS_KLAT), (bf16*)(ws + WS_VTCTX), (bf16*)(ws + WS_VTLAT), (bf16*)(ws + WS_BG), (bf16*)(ws + WS_Z),
                      args.out + OUT_NK, args.out + OUT_NV, (const float*)(ws + WS_MISC + 128 * 1024), (const float*)(ws + WS_MISC + 128 * 1024) + 1024};
        pg8::gemm_phase<pg8::EpiMix, pg8::StaticOrder, true, true>(F.lds, g, S, E); } SEAM(5);
    if (IN(6)) REP(6) { attn_conv_phase(F, args, 7); } SEAM(6);
    if (IN(7)) REP(7) { pg8::Gemm g{(const bf16*)(ws + WS_MIX), (const bf16*)(ws + WS_WO), M, D, D}; pg8::StaticOrder S; S.init(M, D, F.G, F.bx); pg8::EpiY E{Y, D};
        pg8::gemm_phase<pg8::EpiY, pg8::StaticOrder, true, true>(F.lds, g, S, E); } SEAM(7);
    if (IN(8)) REP(8) { row_phase(F, args, 2); } SEAM(8);
    if (IN(9)) REP(9) { pg8::Gemm g{U, (const bf16*)(ws + WS_W2U), M, NUP, D}; pg8::StaticOrder S; S.init(M, NUP, F.G, F.bx); pg8::EpiSwiGLU E{Gb, FF};
        pg8::gemm_phase<pg8::EpiSwiGLU, pg8::StaticOrder, true, true>(F.lds, g, S, E); } SEAM(9);
    if (IN(10)) REP(10) { pg8::Gemm g{Gb, (const bf16*)(ws + WS_W2D), M, D, FF}; pg8::StaticOrder S; S.init(M, D, F.G, F.bx); pg8::EpiY E{Y, D};
        pg8::gemm_phase<pg8::EpiY, pg8::StaticOrder, true, true>(F.lds, g, S, E); } SEAM(10);
    if (IN(11)) REP(11) { row_phase(F, args, 3); }
#undef IN
#undef SEAM
}

extern "C" void kernel_launch(void* const* d_in, const int* in_sizes, int n_in, void* d_out, int out_size, void* d_ws, size_t ws_size, hipStream_t stream) {
    static int grid = 0;
    if (grid == 0) {
        if (n_in != 19 || ws_size < WS_END) { fprintf(stderr, "kernel_launch: unexpected n_in %d / ws %zu\n", n_in, ws_size); grid = -1; return; }
        int dev = 0, cus = 0, per_cu = 0;
        if (hipGetDevice(&dev) != hipSuccess || hipDeviceGetAttribute(&cus, hipDeviceAttributeMultiprocessorCount, dev) != hipSuccess) { grid = -1; return; }
        if (hipFuncSetAttribute((const void*)fwd_mk, hipFuncAttributeMaxDynamicSharedMemorySize, LDS_BYTES) != hipSuccess) { fprintf(stderr, "kernel_launch: hipFuncSetAttribute failed\n"); grid = -1; return; }
        if (hipOccupancyMaxActiveBlocksPerMultiprocessor(&per_cu, (const void*)fwd_mk, NWAVES * 64, LDS_BYTES) != hipSuccess || per_cu < 1) fprintf(stderr, "kernel_launch: occupancy query says %d\n", per_cu);
        (void)hipGetLastError();
        grid = cus;
    }
    if (grid < 0) return;
    (void)hipMemsetAsync((char*)d_ws + WS_CTL, 0, CTL_ZERO_BYTES, stream);
    Args a{};
    for (int i = 0; i < 19; ++i) a.in[i] = (const float*)d_in[i];
    a.out = (float*)d_out; a.ws = (unsigned char*)d_ws;
#if MK_N_LAUNCHES == 1
    a.ph_lo = 0; a.ph_hi = NPH; a.li = 0;
    void* kargs[] = {&a};
    hipError_t e = hipLaunchCooperativeKernel((const void*)fwd_mk, dim3(grid), dim3(NWAVES * 64), kargs, LDS_BYTES, stream);
    if (e != hipSuccess) fprintf(stderr, "kernel_launch: cooperative launch failed: %s (grid %d)\n", hipGetErrorString(e), grid);
#else
    for (int li = 0; li < NPH; ++li) { a.ph_lo = li; a.ph_hi = li + 1; a.li = li; hipLaunchKernelGGL(fwd_mk, dim3(grid), dim3(NWAVES * 64), LDS_BYTES, stream, a); }
#endif
}
```

```cpp
#include <hip/hip_runtime.h>
#include <hip/hip_cooperative_groups.h>
#include <cstdio>
#include <cstdint>
#ifndef MK_N_LAUNCHES
#define MK_N_LAUNCHES 1
#endif
namespace pg8 {
#define PG8_LAS __attribute__((address_space(3)))
typedef unsigned short bf16_t;
typedef short bf16x8 __attribute__((ext_vector_type(8)));
typedef float f32x4 __attribute__((ext_vector_type(4)));
typedef unsigned u32x4 __attribute__((ext_vector_type(4)));
constexpr int BM = 256, BK = 64, HALF = 128, HTB = HALF * BK * 2  , STAGE_BYTES = 8 * HTB, NXCD = 8, WGM = 8;

__host__ __device__ __forceinline__ int lds_byte(int r, int c) { const int st = (r >> 4) * 2 + (c >> 5), rr = r & 15, cc = c & 31, ob = rr * 64 + cc * 2; return st * 1024 + (ob ^ (((ob >> 9) & 1) << 5)); }
__host__ __device__ __forceinline__ void stage_rc(int b, int& R, int& C) { const int st = b / 1024, sb = b % 1024, swz = sb ^ (((sb >> 9) & 1) << 5); R = (st >> 1) * 16 + swz / 64; C = (st & 1) * 32 + (swz % 64) / 2; }
__host__ __device__ __forceinline__ int perm32(int rho) { const int n = rho >> 4, i = rho & 15; return 8 * (i >> 2) + 4 * n + (i & 3); }

struct Unit { int pm, pn, half; };
struct Gemm { const bf16_t* A; const bf16_t* Bt; int M, N, K; };

struct StaticOrder {
    int nM, nN, nwg, G, c;
    __host__ __device__ void init(int M, int N, int G_, int c_) { nM = M / BM; nN = N / BM; nwg = nM * nN; G = G_; c = c_; }
    __host__ __device__ bool next(int i, Unit& u) const {
        const long L = (long)i * G + c; if (L >= nwg) return false;
        int wgid = (int)L; { const int q = nwg / NXCD, r = nwg % NXCD, xcd = wgid % NXCD, off = wgid / NXCD; wgid = (xcd < r ? xcd * (q + 1) : r * (q + 1) + (xcd - r) * q) + off; }
        const int nig = WGM * nN, gid = wgid / nig, fm = gid * WGM, gsz = (nM - fm) < WGM ? (nM - fm) : WGM;
        u.pm = fm + ((wgid % nig) % gsz); u.pn = (wgid % nig) / gsz; u.half = 0; return true;
    }
    __device__ __forceinline__ void a_ready(const Unit&) const {}
    __device__ __forceinline__ void done(const Unit&) const {}
};
struct TailSplitOrder {
    int nM, nN, nwg, G, c, nfull, nitems;
    __host__ __device__ void init(int M, int N, int G_, int c_) { nM = M / BM; nN = N / BM; nwg = nM * nN; G = G_; c = c_; nfull = (nwg / G) * G; const int rem = nwg - nfull;
        if (2 * rem > G) { nfull = nwg; } nitems = nfull + 2 * (nwg - nfull); }
    __host__ __device__ bool next(int i, Unit& u) const {
        const long L = (long)i * G + c; if (L >= nitems) return false;
        int wgid, half; if (L < nfull) { wgid = (int)L; half = 0; } else { wgid = nfull + (int)(L - nfull) / 2; half = 1 + (int)((L - nfull) & 1); }
        { const int q = nwg / NXCD, r = nwg % NXCD, xcd = wgid % NXCD, off = wgid / NXCD; wgid = (xcd < r ? xcd * (q + 1) : r * (q + 1) + (xcd - r) * q) + off; }
        const int nig = WGM * nN, gid = wgid / nig, fm = gid * WGM, gsz = (nM - fm) < WGM ? (nM - fm) : WGM;
        u.pm = fm + ((wgid % nig) % gsz); u.pn = (wgid % nig) / gsz; u.half = half; return true;
    }
    __device__ __forceinline__ void a_ready(const Unit&) const {}
    __device__ __forceinline__ void done(const Unit&) const {}
};
typedef float f32x2c __attribute__((ext_vector_type(2))); typedef __bf16 bf16x2c __attribute__((ext_vector_type(2)));
__device__ __forceinline__ unsigned cvt_pk_bf16(float lo, float hi) { const f32x2c v = {lo, hi}; const bf16x2c b = __builtin_convertvector(v, bf16x2c); return __builtin_bit_cast(unsigned, b); }
typedef float f32x2 __attribute__((ext_vector_type(2)));
typedef unsigned u32x2 __attribute__((ext_vector_type(2)));
__device__ __forceinline__ f32x4 silu_mul(f32x4 a, f32x4 b) {
    f32x4 o;
#pragma unroll
    for (int j = 0; j < 4; ++j) { const float e = __builtin_amdgcn_exp2f(a[j] * -1.4426950408889634f); o[j] = a[j] * b[j] * __builtin_amdgcn_rcpf(1.0f + e); }
    return o;
}
struct EpiSwiGLU {
    static constexpr bool PERM = false, AFTER_DRAIN = false;
    bf16_t* G; int ldg;
    __device__ __forceinline__ void operator()(const f32x4 (&acc)[2][2][4][2], const Unit& u, int wr, int wc, int fr, int fq) const {
        const int row0 = u.pm * BM + wr * 64 + fr, col0 = u.pn * HALF + wc * 32 + 8 * fq;
#pragma unroll
        for (int ai = 0; ai < 2; ++ai) { if (u.half && u.half != ai + 1) continue;
#pragma unroll
            for (int m = 0; m < 4; ++m) {
                const f32x4 g0 = silu_mul(acc[ai][0][m][0], acc[ai][1][m][0]), g1 = silu_mul(acc[ai][0][m][1], acc[ai][1][m][1]);
                u32x4 w; w.x = cvt_pk_bf16(g0[0], g0[1]); w.y = cvt_pk_bf16(g0[2], g0[3]); w.z = cvt_pk_bf16(g1[0], g1[1]); w.w = cvt_pk_bf16(g1[2], g1[3]);
                *(u32x4*)(G + (size_t)(row0 + ai * HALF + m * 16) * ldg + col0) = w; } }
    }
};
struct EpiY {
    static constexpr bool PERM = false, AFTER_DRAIN = false;
    bf16_t* C; int ldc;
    __device__ __forceinline__ void operator()(const f32x4 (&acc)[2][2][4][2], const Unit& u, int wr, int wc, int fr, int fq) const {
        const int row0 = u.pm * BM + wr * 64 + fr, col0 = u.pn * BM + wc * 32 + 8 * fq;
#pragma unroll
        for (int ai = 0; ai < 2; ++ai)
#pragma unroll
            for (int m = 0; m < 4; ++m) { bf16_t* rowp = C + (size_t)(row0 + ai * HALF + m * 16) * ldc + col0;
#pragma unroll
                for (int bj = 0; bj < 2; ++bj) { const f32x4 v0 = acc[ai][bj][m][0], v1 = acc[ai][bj][m][1];
                    u32x4 w; w.x = cvt_pk_bf16(v0[0], v0[1]); w.y = cvt_pk_bf16(v0[2], v0[3]); w.z = cvt_pk_bf16(v1[0], v1[1]); w.w = cvt_pk_bf16(v1[2], v1[3]); *(u32x4*)(rowp + bj * HALF) = w; } }
    }
};
struct EpiMix {
    static constexpr bool PERM = false, AFTER_DRAIN = false;
    bf16_t *Qb, *Kctx, *Klat, *Vtctx, *Vtlat, *BGb, *Zb; float *newk, *newv; const float *ropeC, *ropeS;
    __device__ __forceinline__ void operator()(const f32x4 (&acc)[2][2][4][2], const Unit& u, int wr, int wc, int fr, int fq) const {
        const int pn = u.pn, pm = u.pm; const bool lat = pm >= 32;
        const int lb = (pm - 32) >> 2, lt0 = ((pm - 32) & 3) * 256;
        const float C2 = 0.125f * 1.4426950408889634f;
        if (pn < 4) {
            const bool isk = pn >= 2; const int colbase = (pn & 1) * 256 + wc * 32 + 4 * fq;
#pragma unroll
            for (int ai = 0; ai < 2; ++ai)
#pragma unroll
                for (int m = 0; m < 4; ++m) {
                    const int rl = wr * 64 + fr + ai * HALF + m * 16, R = pm * BM + rl, t = lt0 + rl;
                    f32x4 c4 = {1.f, 1.f, 1.f, 1.f}, s4 = {0.f, 0.f, 0.f, 0.f};
                    if (lat) { const int pos = (wc & 1) ? (t & 63) : (t >> 6); c4 = *(const f32x4*)(ropeC + pos * 16 + 4 * fq); s4 = *(const f32x4*)(ropeS + pos * 16 + 4 * fq); }
                    bf16_t* dst = !isk ? Qb + (size_t)R * 512 : (lat ? Klat + (size_t)(lb * 1536 + 512 + t) * 512 : Kctx + (size_t)R * 512);
#pragma unroll
                    for (int bj = 0; bj < 2; ++bj) {
                        f32x4 x1 = acc[ai][bj][m][0], x2 = acc[ai][bj][m][1];
                        const int col = colbase + bj * HALF;
                        if (isk && !lat) { *(f32x4*)(newk + (size_t)R * 512 + col) = x1; *(f32x4*)(newk + (size_t)R * 512 + col + 16) = x2; }
                        const f32x4 y1 = x1 * c4 - x2 * s4, y2 = x2 * c4 + x1 * s4; x1 = y1; x2 = y2;
                        if (!isk) { x1 = x1 * C2; x2 = x2 * C2; }
                        u32x4 w; w.x = cvt_pk_bf16(x1[0], x1[1]); w.y = cvt_pk_bf16(x1[2], x1[3]); w.z = cvt_pk_bf16(x2[0], x2[1]); w.w = cvt_pk_bf16(x2[2], x2[3]);
                        *(u32x4*)(dst + (pn & 1) * 256 + bj * HALF + wc * 32 + 8 * fq) = w; } }
        } else if (pn < 6) {
            const int colbase = (pn - 4) * 256 + wc * 32 + 4 * fq;
#pragma unroll
            for (int ai = 0; ai < 2; ++ai)
#pragma unroll
                for (int m = 0; m < 4; ++m) {
                    const int rl = wr * 64 + fr + ai * HALF + m * 16, R = pm * BM + rl, t = lt0 + rl;
                    bf16_t* vt = lat ? Vtlat + (size_t)(lb * 512) * 1536 + 512 + t : Vtctx + (size_t)(pm * 512) * 256 + rl;
                    const size_t ldv = lat ? 1536 : 256;
#pragma unroll
                    for (int bj = 0; bj < 2; ++bj)
#pragma unroll
                        for (int n = 0; n < 2; ++n) { const f32x4 v = acc[ai][bj][m][n]; const int col = colbase + bj * HALF + n * 16;
                            if (!lat) *(f32x4*)(newv + (size_t)R * 512 + col) = v;
                            const unsigned p01 = cvt_pk_bf16(v[0], v[1]), p23 = cvt_pk_bf16(v[2], v[3]);
                            vt[(size_t)(col + 0) * ldv] = (bf16_t)(p01 & 0xffffu); vt[(size_t)(col + 1) * ldv] = (bf16_t)(p01 >> 16);
                            vt[(size_t)(col + 2) * ldv] = (bf16_t)(p23 & 0xffffu); vt[(size_t)(col + 3) * ldv] = (bf16_t)(p23 >> 16); } }
        } else if (pn < 8) {
            const int colbase = (pn - 6) * 256 + wc * 32 + 8 * fq;
#pragma unroll
            for (int ai = 0; ai < 2; ++ai)
#pragma unroll
                for (int m = 0; m < 4; ++m) { bf16_t* dst = BGb + (size_t)(pm * BM + wr * 64 + fr + ai * HALF + m * 16) * 512 + colbase;
#pragma unroll
                    for (int bj = 0; bj < 2; ++bj) { const f32x4 v0 = acc[ai][bj][m][0], v1 = acc[ai][bj][m][1];
                        u32x4 w; w.x = cvt_pk_bf16(v0[0], v0[1]); w.y = cvt_pk_bf16(v0[2], v0[3]); w.z = cvt_pk_bf16(v1[0], v1[1]); w.w = cvt_pk_bf16(v1[2], v1[3]); *(u32x4*)(dst + bj * HALF) = w; } }
        } else {
            const int col0 = (pn - 8) * HALF + wc * 32 + 8 * fq;
#pragma unroll
            for (int ai = 0; ai < 2; ++ai)
#pragma unroll
                for (int m = 0; m < 4; ++m) { const f32x4 z0 = acc[ai][0][m][0] * acc[ai][1][m][0], z1 = acc[ai][0][m][1] * acc[ai][1][m][1];
                    u32x4 w; w.x = cvt_pk_bf16(z0[0], z0[1]); w.y = cvt_pk_bf16(z0[2], z0[3]); w.z = cvt_pk_bf16(z1[0], z1[1]); w.w = cvt_pk_bf16(z1[2], z1[3]);
                    *(u32x4*)(Zb + (size_t)(pm * BM + wr * 64 + fr + ai * HALF + m * 16) * 512 + col0) = w; }
        }
    }
};
template <class Epi, class Sched, bool ALIGN_EPI = false, bool SP2 = false, bool HALFABLE = false>
__device__ __forceinline__ void gemm_phase(PG8_LAS unsigned char* lds, const Gemm g, const Sched& S, const Epi& E) {
    const int tid = threadIdx.x, wid = __builtin_amdgcn_readfirstlane(tid >> 6), lane = tid & 63, wr = wid >> 2, wc = wid & 3, fr = lane & 15, fq = lane >> 4;
    const int K = g.K, nt = K / BK;
    unsigned voffA[2], voffB[2];
#pragma unroll
    for (int i = 0; i < 2; ++i) { int R, C; stage_rc(tid * 16 + i * 8192, R, C); const int Rb = Epi::PERM ? ((R & ~31) + perm32(R & 31)) : R;
        voffA[i] = (unsigned)(R * K + C) * 2u; voffB[i] = (unsigned)(Rb * K + C) * 2u; }
    const size_t kstep = (size_t)(BK * 2);
    const size_t hstep = (size_t)HALF * K * 2;
    const size_t tstep = 2 * hstep;
    const unsigned ldsw = (unsigned)wid * 1024u;
    const int aoff = lds_byte(wr * 64 + fr, fq * 8), boff = lds_byte(wc * 32 + fr, fq * 8);
#define PG8_SA(b, h) (((b) * 2 + (h)) * HTB)
#define PG8_SB(b, h) ((4 + (b) * 2 + (h)) * HTB)
#define PG8_STAGE(bufoff, gbase, voff) do { _Pragma("unroll") for (int _i = 0; _i < 2; ++_i) \
        __builtin_amdgcn_global_load_lds((const unsigned*)((const char*)(gbase) + (voff)[_i]), (PG8_LAS unsigned*)(lds + (bufoff) + ldsw + _i * 8192), 16, 0, 0); } while (0)
#define PG8_LDA(dst, b, h) do { _Pragma("unroll") for (int m = 0; m < 4; ++m) _Pragma("unroll") for (int k = 0; k < 2; ++k) dst[m][k] = *(const PG8_LAS bf16x8*)(lds + PG8_SA(b, h) + aoff + m * 2048 + k * 1024); } while (0)
#define PG8_LDB(dst, b, h) do { _Pragma("unroll") for (int n = 0; n < 2; ++n) _Pragma("unroll") for (int k = 0; k < 2; ++k) dst[n][k] = *(const PG8_LAS bf16x8*)(lds + PG8_SB(b, h) + boff + n * 2048 + k * 1024); } while (0)
#define PG8_MMA(ai, bj, At, Bt) do { __builtin_amdgcn_s_setprio(1); _Pragma("unroll") for (int m = 0; m < 4; ++m) _Pragma("unroll") for (int n = 0; n < 2; ++n) _Pragma("unroll") for (int k = 0; k < 2; ++k) \
        acc[ai][bj][m][n] = __builtin_amdgcn_mfma_f32_16x16x32_bf16(Bt[n][k], At[m][k], acc[ai][bj][m][n], 0, 0, 0); __builtin_amdgcn_s_setprio(0); } while (0)
#define PG8_WAIT_V(n) asm volatile("s_waitcnt vmcnt(" #n ")" ::: "memory")
#define PG8_WAIT_L(n) asm volatile("s_waitcnt lgkmcnt(" #n ")" ::: "memory")
#define PG8_BAR __builtin_amdgcn_s_barrier()
#define PG8_SCHED __builtin_amdgcn_sched_barrier(0)
    Unit cur, nxt; int ui = 0;
    if (!S.next(0, cur)) return;
    f32x4 acc[2][2][4][2];
#pragma unroll
    for (int a = 0; a < 2; ++a)
#pragma unroll
        for (int b = 0; b < 2; ++b)
#pragma unroll
            for (int m = 0; m < 4; ++m)
#pragma unroll
                for (int n = 0; n < 2; ++n) acc[a][b][m][n] = (f32x4){0.f, 0.f, 0.f, 0.f};
    bf16x8 At[4][2], B0[2][2], B1[2][2];
    const char* cA = (const char*)g.A + (size_t)cur.pm * tstep; const char* cB = (const char*)g.Bt + (size_t)cur.pn * tstep;
    S.a_ready(cur);
    if constexpr (SP2) {
        PG8_STAGE(PG8_SB(0, 0), cB, voffB); PG8_STAGE(PG8_SB(0, 1), cB + hstep, voffB); PG8_STAGE(PG8_SA(0, 0), cA, voffA); PG8_STAGE(PG8_SA(0, 1), cA + hstep, voffA);
        if (wr == 1) PG8_BAR;
        PG8_WAIT_V(2); PG8_BAR;
        PG8_STAGE(PG8_SB(1, 0), cB + kstep, voffB); PG8_STAGE(PG8_SA(1, 0), cA + kstep, voffA); PG8_STAGE(PG8_SB(1, 1), cB + hstep + kstep, voffB);
        PG8_WAIT_V(6); PG8_BAR;
    } else {
        PG8_STAGE(PG8_SB(0, 0), cB, voffB); PG8_STAGE(PG8_SA(0, 0), cA, voffA); PG8_STAGE(PG8_SB(0, 1), cB + hstep, voffB); PG8_STAGE(PG8_SA(0, 1), cA + hstep, voffA);
        if (wr == 1) PG8_BAR;
        PG8_WAIT_V(4); PG8_BAR;
        PG8_STAGE(PG8_SB(1, 0), cB + kstep, voffB); PG8_STAGE(PG8_SA(1, 0), cA + kstep, voffA); PG8_STAGE(PG8_SB(1, 1), cB + hstep + kstep, voffB);
        PG8_WAIT_V(6); PG8_BAR;
    }
    for (;;) {
        const bool has_next = S.next(ui + 1, nxt);
        const bool do0 = !HALFABLE || cur.half != 2, do1 = !HALFABLE || cur.half != 1;
        const char* nA = has_next ? (const char*)g.A + (size_t)nxt.pm * tstep : cA; const char* nB = has_next ? (const char*)g.Bt + (size_t)nxt.pn * tstep : cB;
        for (int t = 0; t < nt; t += 2) {
            const bool last = (t == nt - 2);
            const char* a1 = cA + (size_t)(t + 1) * kstep;
            const char* a2 = last ? nA : cA + (size_t)(t + 2) * kstep; const char* b2 = last ? nB : cB + (size_t)(t + 2) * kstep;
            const char* a3 = a2 + kstep; const char* b3 = b2 + kstep;
            if (last && has_next) S.a_ready(nxt);
            if constexpr (SP2) {
            PG8_LDB(B0, 0, 0); PG8_LDB(B1, 0, 1); PG8_SCHED; if (do0) PG8_LDA(At, 0, 0); PG8_STAGE(PG8_SA(1, 1), a1 + hstep, voffA);
            PG8_WAIT_V(8); PG8_WAIT_L(0); PG8_BAR; if (do0) { PG8_MMA(0, 0, At, B0); PG8_MMA(0, 1, At, B1); } PG8_BAR; PG8_SCHED;
            if (do1) PG8_LDA(At, 0, 1); PG8_STAGE(PG8_SB(0, 0), b2, voffB); PG8_STAGE(PG8_SB(0, 1), b2 + hstep, voffB); PG8_STAGE(PG8_SA(0, 0), a2, voffA);
            PG8_WAIT_V(8); PG8_WAIT_L(0); PG8_BAR; if (do1) { PG8_MMA(1, 0, At, B0); PG8_MMA(1, 1, At, B1); } PG8_BAR; PG8_SCHED;
            PG8_LDB(B0, 1, 0); PG8_LDB(B1, 1, 1); PG8_SCHED; if (do0) PG8_LDA(At, 1, 0); PG8_STAGE(PG8_SA(0, 1), a2 + hstep, voffA);
            PG8_WAIT_V(8); PG8_WAIT_L(0); PG8_BAR; if (do0) { PG8_MMA(0, 0, At, B0); PG8_MMA(0, 1, At, B1); } PG8_BAR; PG8_SCHED;
            if (do1) PG8_LDA(At, 1, 1); PG8_STAGE(PG8_SB(1, 0), b3, voffB); PG8_STAGE(PG8_SB(1, 1), b3 + hstep, voffB); PG8_STAGE(PG8_SA(1, 0), a3, voffA);
            PG8_WAIT_V(8); PG8_WAIT_L(0); PG8_BAR; if (do1) { PG8_MMA(1, 0, At, B0); PG8_MMA(1, 1, At, B1); } PG8_BAR; PG8_SCHED;
            } else {
            PG8_LDB(B0, 0, 0); PG8_SCHED; PG8_LDA(At, 0, 0); PG8_STAGE(PG8_SA(1, 1), a1 + hstep, voffA);
            PG8_WAIT_L(8); PG8_BAR; PG8_WAIT_L(0); PG8_MMA(0, 0, At, B0); PG8_BAR; PG8_SCHED;
            PG8_LDB(B1, 0, 1); PG8_STAGE(PG8_SB(0, 0), b2, voffB);
            PG8_BAR; PG8_WAIT_L(0); PG8_MMA(0, 1, At, B1); PG8_BAR;
            PG8_LDA(At, 0, 1); PG8_STAGE(PG8_SA(0, 0), a2, voffA);
            PG8_BAR; PG8_WAIT_L(0); PG8_MMA(1, 0, At, B0); PG8_BAR; PG8_SCHED;
            PG8_STAGE(PG8_SB(0, 1), b2 + hstep, voffB);
            PG8_WAIT_V(6); PG8_BAR; PG8_MMA(1, 1, At, B1); PG8_BAR;
            PG8_LDB(B0, 1, 0); PG8_SCHED; PG8_LDA(At, 1, 0); PG8_STAGE(PG8_SA(0, 1), a2 + hstep, voffA);
            PG8_WAIT_L(8); PG8_BAR; PG8_WAIT_L(0); PG8_MMA(0, 0, At, B0); PG8_BAR; PG8_SCHED;
            PG8_LDB(B1, 1, 1); PG8_STAGE(PG8_SB(1, 0), b3, voffB);
            PG8_BAR; PG8_WAIT_L(0); PG8_MMA(0, 1, At, B1); PG8_BAR;
            PG8_LDA(At, 1, 1); PG8_STAGE(PG8_SA(1, 0), a3, voffA);
            PG8_BAR; PG8_WAIT_L(0); PG8_MMA(1, 0, At, B0); PG8_BAR; PG8_SCHED;
            PG8_STAGE(PG8_SB(1, 1), b3 + hstep, voffB);
            PG8_WAIT_V(6); PG8_BAR; PG8_MMA(1, 1, At, B1); PG8_BAR;
            }
        }
        if constexpr (ALIGN_EPI) { if (wr == 0) PG8_BAR; }
        if constexpr (!Epi::AFTER_DRAIN) { E(acc, cur, wr, wc, fr, fq); S.done(cur); }
        if (!has_next) break;
#pragma unroll
        for (int a = 0; a < 2; ++a)
#pragma unroll
            for (int b = 0; b < 2; ++b)
#pragma unroll
                for (int m = 0; m < 4; ++m)
#pragma unroll
                    for (int n = 0; n < 2; ++n) acc[a][b][m][n] = (f32x4){0.f, 0.f, 0.f, 0.f};
        cur = nxt; cA = nA; cB = nB; ++ui;
        if constexpr (ALIGN_EPI) { if (wr == 1) PG8_BAR; }
    }
    PG8_WAIT_V(0);
    if constexpr (!ALIGN_EPI) { if (wr == 0) PG8_BAR; }
    PG8_BAR;
    if constexpr (Epi::AFTER_DRAIN) { E.fused(acc, cur, wr, wc, fr, fq, lds, wid, lane); S.done(cur); }
#undef PG8_SA
#undef PG8_SB
#undef PG8_STAGE
#undef PG8_LDA
#undef PG8_LDB
#undef PG8_MMA
#undef PG8_WAIT_V
#undef PG8_WAIT_L
#undef PG8_BAR
#undef PG8_SCHED
}
}
constexpr int NWAVES = 8;
constexpr int D = 1024, MC = 8192, MLAT = 2048, M = MC + MLAT, FF = 2816, NUP = 2 * FF, NIN = 3072, AW = 512;
constexpr int TC = 256, TL = 1024, PAST = 512, TKL = PAST + TL, NMODC = 9 * D;
constexpr float EPS = 1e-6f;
constexpr size_t OUT_Y = 0, OUT_NK = (size_t)M * D, OUT_NV = OUT_NK + (size_t)MC * AW;
constexpr size_t MiB = 1u << 20, HMiB = 1u << 19;
constexpr size_t WS_CTL = 0, CTL_ZERO_BYTES = 64 * 1024;
constexpr size_t WS_MISC = 1 * MiB;
constexpr size_t WS_W1U = 2 * MiB, WS_W1D = 13 * MiB, WS_W2U = 13 * MiB + 11 * HMiB, WS_W2D = WS_W2U + 11 * MiB, WS_WIN = 35 * MiB, WS_WO = 41 * MiB;
constexpr size_t WS_KLAT = 43 * MiB, WS_VTLAT = 46 * MiB, WS_U = 49 * MiB, WS_Y = 69 * MiB, WS_X1 = 109 * MiB, WS_R = 149 * MiB;
constexpr size_t WS_G = WS_R, WS_QB = WS_R, WS_KCTX = WS_R + 10 * MiB, WS_VTCTX = WS_R + 18 * MiB, WS_BG = WS_R + 26 * MiB, WS_Z = WS_R + 36 * MiB, WS_MIX = WS_R + 46 * MiB;
constexpr size_t WS_END = WS_R + 66 * MiB;
static_assert(WS_W2D + 11 * HMiB == WS_WIN && WS_G + (size_t)M * FF * 2 <= WS_END && WS_END <= 256 * MiB, "ws map");
constexpr int CW_BAR = 1024;
constexpr int RING_BYTES = 131072, LDSCTL_OFF = RING_BYTES, MISC_OFF = LDSCTL_OFF + 320, LDS_BYTES = 147456;

#define GAS __attribute__((address_space(1)))
#define LAS __attribute__((address_space(3)))
typedef unsigned short bf16;
typedef unsigned v4u __attribute__((ext_vector_type(4)));
typedef unsigned v2u __attribute__((ext_vector_type(2)));
typedef float f32x4 __attribute__((ext_vector_type(4)));
typedef float f32x16 __attribute__((ext_vector_type(16)));
typedef short bf16x8 __attribute__((ext_vector_type(8)));
typedef short s16x4 __attribute__((ext_vector_type(4)));
#define LDS_WAIT() asm volatile("s_waitcnt lgkmcnt(0)" ::: "memory")
__device__ __forceinline__ unsigned f2bf(float f) { unsigned u = __builtin_bit_cast(unsigned, f); return (u + 0x7fffu + ((u >> 16) & 1u)) >> 16; }
typedef float f32x2_t __attribute__((ext_vector_type(2)));
typedef __bf16 bf16x2_t __attribute__((ext_vector_type(2)));
__device__ __forceinline__ unsigned pk2(float lo, float hi) { const f32x2_t v = {lo, hi}; const bf16x2_t b = __builtin_convertvector(v, bf16x2_t); return __builtin_bit_cast(unsigned, b); }
#define XB_TMO      128
#define XB_XCNT(j)  (256  + 64 * (j))
#define XB_XSUB(j)  (1280 + 64 * (j))
#define XB_XGEN(j)  (2304 + 64 * (j))
#define XB_TOP      3328
#define XB_TOPGEN   3392
#define XCD_BAR_WORDS 3456
#define XB_SPIN_CAP (1u << 18)

__device__ __forceinline__ unsigned xb_ld(unsigned* p)              { return __hip_atomic_load(p, __ATOMIC_RELAXED, __HIP_MEMORY_SCOPE_AGENT); }
__device__ __forceinline__ unsigned xb_add(unsigned* p, unsigned v) { return __hip_atomic_fetch_add(p, v, __ATOMIC_RELAXED, __HIP_MEMORY_SCOPE_AGENT); }
__device__ __forceinline__ unsigned xb_xcc_id() { return (unsigned)__builtin_amdgcn_s_getreg((3 << 11) | 20) & 0xFu; }
#define XB_SPIN(cond, bar) do { unsigned _sp = 0; while (cond) { __builtin_amdgcn_s_sleep(1); \
    if ((++_sp & 255u) == 0u) { if (xb_ld(&(bar)[XB_TMO])) break; if (_sp > XB_SPIN_CAP) { atomicAdd(&(bar)[XB_TMO], 1u); break; } } } } while (0)

struct XcdBarrier {
    unsigned* bar; unsigned x;
    volatile LAS unsigned* st;
};

__device__ __forceinline__ XcdBarrier xcd_barrier_post(unsigned* bar, volatile LAS unsigned* st) {
    XcdBarrier b; b.bar = bar; b.x = xb_xcc_id(); b.st = st;
    if (threadIdx.x == 0) (void)xb_add(&bar[XB_XCNT(b.x)], 1u);
    return b;
}
__device__ __forceinline__ void xcd_barrier_complete(unsigned* bar, unsigned x, unsigned& nloc, unsigned& nx) {
    const unsigned G = gridDim.x * gridDim.y * gridDim.z;
    unsigned sum, cnt, mine, sp = 0u;
    for (;;) {
        sum = 0u; cnt = 0u; mine = 0u;
#pragma unroll
        for (unsigned j = 0; j < 16; ++j) { const unsigned c = xb_ld(&bar[XB_XCNT(j)]); sum += c; cnt += (c > 0u) ? 1u : 0u; mine = (j == x) ? c : mine; }
        if (sum == G) break;
        __builtin_amdgcn_s_sleep(1);
        if ((++sp & 255u) == 0u) { if (xb_ld(&bar[XB_TMO])) break; if (sp > XB_SPIN_CAP) { atomicAdd(&bar[XB_TMO], 1u); break; } }
    }
    nloc = mine > 0u ? mine : 1u; nx = cnt > 0u ? cnt : 1u;
}

__device__ __forceinline__ void xcd_barrier(const XcdBarrier& b) {
    asm volatile("s_waitcnt vmcnt(0)" ::: "memory");
    __syncthreads();
    if (threadIdx.x == 0) {
        unsigned* bar = b.bar;
        __builtin_amdgcn_s_waitcnt(0);
        unsigned nloc = b.st[0], nx = b.st[1];
        if (nloc == 0u) { xcd_barrier_complete(bar, b.x, nloc, nx); b.st[0] = nloc; b.st[1] = nx; }
        const unsigned old = xb_add(&bar[XB_XSUB(b.x)], 1u);
        const unsigned gen = old / nloc;
        if (old + 1u == (gen + 1u) * nloc) {
            __builtin_amdgcn_fence(__ATOMIC_RELEASE, "agent");
            asm volatile("s_waitcnt vmcnt(0)" ::: "memory");
            const unsigned og = xb_add(&bar[XB_TOP], 1u);
            const unsigned tg = og / nx;
            if (og + 1u == (tg + 1u) * nx) {
                xb_add(&bar[XB_TOPGEN], 1u); xb_add(&bar[XB_XGEN(b.x)], 1u);
                __builtin_amdgcn_fence(__ATOMIC_ACQUIRE, "agent");
            } else {
                __builtin_amdgcn_fence(__ATOMIC_ACQUIRE, "agent");
                XB_SPIN(xb_ld(&bar[XB_TOPGEN]) == tg, bar);
                xb_add(&bar[XB_XGEN(b.x)], 1u);
            }
            asm volatile("s_waitcnt vmcnt(0)" ::: "memory");
        } else {
            __builtin_amdgcn_fence(__ATOMIC_ACQUIRE, "agent");
            XB_SPIN(xb_ld(&bar[XB_XGEN(b.x)]) == gen, bar);
            asm volatile("s_waitcnt vmcnt(0)" ::: "memory");
        }
    }
    __syncthreads();
}
struct Args { const float* in[19]; float* out; unsigned char* ws; int ph_lo, ph_hi, li, pad; };
struct Frame {
    LAS unsigned char* lds; int tid, lane, wave, G, bx;
};
__device__ __forceinline__ float wave_sum(float v) {
#pragma unroll
    for (int o = 1; o < 64; o <<= 1) v += __shfl_xor(v, o);
    return v;
}
__device__ __forceinline__ int slot5(int i) { return 16 * ((i >> 2) & 1) + 4 * (i >> 3) + (i & 3); }
__device__ __forceinline__ int dest_row(int mode, int c) {
    if (mode == 1) { const int hs = c >= FF ? 1 : 0, j = c - FF * hs; return 256 * (j >> 7) + 128 * hs + (j & 96) + slot5(j & 31); }
    if (mode == 2) { if (c < 1536) return c; if (c < 2048) return (c & ~31) + slot5(c & 31);     const int cc = c - 2048, hs = cc >> 9, j = cc & 511; return 2048 + 256 * (j >> 7) + 128 * hs + (j & 96) + slot5(j & 31); }
    if (mode == 3) return (c & ~31) + slot5(c & 31);
    return c;
}
__device__ __forceinline__ void tr_item(const float* W, int ldw, bf16* WT, size_t ldt, int k0, int n0, int mode, LAS float* scr, int lane) {
#pragma unroll 8
    for (int i = 0; i < 32; ++i) { const int kk = 2 * i + (lane >> 5); scr[kk * 33 + (lane & 31)] = __builtin_nontemporal_load(W + (size_t)(k0 + kk) * ldw + n0 + (lane & 31)); }
    LDS_WAIT(); asm volatile("" ::: "memory");
    const int c = lane & 7;
#pragma unroll
    for (int j = 0; j < 4; ++j) { const int n = (lane >> 3) + 8 * j; const LAS float* s = scr + (8 * c) * 33 + n;
        v4u o; o.x = pk2(s[0 * 33], s[1 * 33]); o.y = pk2(s[2 * 33], s[3 * 33]); o.z = pk2(s[4 * 33], s[5 * 33]); o.w = pk2(s[6 * 33], s[7 * 33]);
        *(v4u*)(WT + (size_t)dest_row(mode, n0 + n) * ldt + k0 + 8 * c) = o; }
    LDS_WAIT(); asm volatile("" ::: "memory");
}
__device__ __forceinline__ void p0_prologue(const Frame& F, const Args& a) {
    unsigned char* ws = a.ws;
    float* mod = (float*)(ws + WS_MISC);
    if (F.bx < NMODC / 64) {
        LAS float* sl = (LAS float*)F.lds;
        for (int i = F.tid; i < 3 * D; i += NWAVES * 64) { const int r = i >> 10, k = i & 1023; const float c = (r == 0) ? a.in[5][k] : a.in[2][(r - 1) * D + k]; sl[i] = c / (1.0f + __expf(-c)); }
        __syncthreads();
        for (int it = F.bx; it < NMODC / 64; it += F.G) {
            const float* w = a.in[6] + (size_t)(128 * F.wave) * NMODC + it * 64 + F.lane;
            float a0 = 0.f, a1 = 0.f, a2 = 0.f;
#pragma unroll 16
            for (int k = 0; k < 128; ++k) { const float wv = __builtin_nontemporal_load(w + (size_t)k * NMODC); const int kk = 128 * F.wave + k; a0 += sl[kk] * wv; a1 += sl[D + kk] * wv; a2 += sl[2 * D + kk] * wv; }
            LAS float* red = (LAS float*)(F.lds + 16384);
            red[(F.wave * 3 + 0) * 64 + F.lane] = a0; red[(F.wave * 3 + 1) * 64 + F.lane] = a1; red[(F.wave * 3 + 2) * 64 + F.lane] = a2;
            __syncthreads();
            if (F.tid < 192) { const int r = F.tid >> 6, l = F.tid & 63; float s = a.in[7][it * 64 + l];
#pragma unroll
                for (int w8 = 0; w8 < 8; ++w8) s += red[(w8 * 3 + r) * 64 + l];
                mod[r * NMODC + it * 64 + l] = s; }
            __syncthreads();
        }
    }
    if (F.bx == F.G - 1) {
        float* rc = (float*)(ws + WS_MISC + 128 * 1024); float* rs = rc + 1024;
        for (int i = F.tid; i < 1024; i += NWAVES * 64) { const int pos = i >> 4, f = i & 15; const float fr = powf(10000.0f, -(float)(2 * f) / 32.0f); float sn, cs; sincosf((float)pos * fr, &sn, &cs); rc[i] = cs; rs[i] = sn; }
    }
    __syncthreads();
    LAS float* scr = (LAS float*)(F.lds + F.wave * 16384);
    const int gw = F.bx * NWAVES + F.wave, NGW = F.G * NWAVES;
    constexpr int I_UP = (D / 64) * (NUP / 32);
    const int h0 = (F.G >= 2 * (NMODC / 64) - 32) ? NMODC / 64 : 0;
    if (F.bx >= h0) for (int r = (F.bx - h0) * NWAVES + F.wave; r < I_UP; r += (F.G - h0) * NWAVES) tr_item(a.in[10], NUP, (bf16*)(ws + WS_W1U), D, 64 * (r / (NUP / 32)), 32 * (r % (NUP / 32)), 1, scr, F.lane);
}
__device__ __forceinline__ void deferred_items(const Frame& F, const Args& a, int set, int hw, int NHW) {
    unsigned char* ws = a.ws;
    LAS float* scr = (LAS float*)(F.lds + F.wave * 16384);
    constexpr int I_UP = (D / 64) * (NUP / 32), I_DN = (FF / 64) * (D / 32), I_IN = (D / 64) * (NIN / 32), I_O = (D / 64) * (D / 32), I_CV = (PAST / 64) * (AW / 32);
    if (set == 0) { for (int r = hw; r < I_DN; r += NHW) tr_item(a.in[11], D, (bf16*)(ws + WS_W1D), FF, 64 * (r / (D / 32)), 32 * (r % (D / 32)), 3, scr, F.lane); return; }
    constexpr int NITEMS = I_UP + I_DN + I_IN + I_O + 2 * I_CV;
    for (int it = hw; it < NITEMS; it += NHW) {
        int r = it;
        if (r < I_UP) { tr_item(a.in[12], NUP, (bf16*)(ws + WS_W2U), D, 64 * (r / (NUP / 32)), 32 * (r % (NUP / 32)), 1, scr, F.lane); continue; } r -= I_UP;
        if (r < I_DN) { tr_item(a.in[13], D, (bf16*)(ws + WS_W2D), FF, 64 * (r / (D / 32)), 32 * (r % (D / 32)), 3, scr, F.lane); continue; } r -= I_DN;
        if (r < I_IN) { tr_item(a.in[14], NIN, (bf16*)(ws + WS_WIN), D, 64 * (r / (NIN / 32)), 32 * (r % (NIN / 32)), 2, scr, F.lane); continue; } r -= I_IN;
        if (r < I_O) { tr_item(a.in[18], D, (bf16*)(ws + WS_WO), D, 64 * (r / (D / 32)), 32 * (r % (D / 32)), 3, scr, F.lane); continue; } r -= I_O;
        { const int b = r / I_CV; r -= b * I_CV;
          tr_item(a.in[4] + (size_t)b * PAST * AW, AW, (bf16*)(ws + WS_VTLAT) + (size_t)b * AW * TKL, TKL, 64 * (r / (AW / 32)), 32 * (r % (AW / 32)), 0, scr, F.lane); }
    }
    for (int i = hw * 64 + F.lane; i < 2 * PAST * AW / 4; i += NHW * 64) {
        const int e = i * 4, b = e / (PAST * AW), rem = e - b * (PAST * AW);
        const f32x4 v = *(const f32x4*)(a.in[3] + e); v2u o; o.x = pk2(v[0], v[1]); o.y = pk2(v[2], v[3]);
        const int d = rem & 31, remp = (rem & ~31) + 8 * ((d >> 2) & 3) + 4 * (d >> 4);
        *(v2u*)((bf16*)(ws + WS_KLAT) + (size_t)b * TKL * AW + remp) = o; }
}
__device__ __forceinline__ const float* xrow_in(const Args& a, int m) { return m < MC ? a.in[0] + (size_t)m * D : a.in[1] + (size_t)(m - MC) * D; }
__device__ __forceinline__ int modrow(int m) { return m < MC ? 0 : 1 + ((m - MC) >> 10); }
__device__ __forceinline__ void norm_mod_store(const f32x4 (&x)[4], const float* g, const float* sh, const float* sc, bf16* urow, int lane) {
    float ss = 0.f;
#pragma unroll
    for (int j = 0; j < 4; ++j) ss += (x[j][0] * x[j][0] + x[j][1] * x[j][1]) + (x[j][2] * x[j][2] + x[j][3] * x[j][3]);
    const float rstd = 1.0f / sqrtf(wave_sum(ss) * (1.0f / D) + EPS);
#pragma unroll
    for (int j = 0; j < 4; ++j) { const int c = 4 * (lane + 64 * j); const f32x4 gv = *(const f32x4*)(g + c), sv = *(const f32x4*)(sh + c), cv = *(const f32x4*)(sc + c);
        const f32x4 u = x[j] * rstd * gv * (cv + 1.0f) + sv; v2u o; o.x = pk2(u[0], u[1]); o.y = pk2(u[2], u[3]); *(v2u*)(urow + c) = o; }
}
__device__ __forceinline__ void row_phase(const Frame& F, const Args& a, int sub) {
    unsigned char* ws = a.ws; const float* mod = (const float*)(ws + WS_MISC);
    const bf16* Y = (const bf16*)(ws + WS_Y); bf16* X1 = (bf16*)(ws + WS_X1); bf16* U = (bf16*)(ws + WS_U);
    const int gw = F.bx * NWAVES + F.wave, NGW = F.G * NWAVES, lane = F.lane;
    int rcur = -1; f32x4 A[4], B[4], C[4];
    for (int m = gw; m < M; m += NGW) {
        const int r = modrow(m);
        if (r != rcur) { rcur = r; const float* mr = mod + r * NMODC;
#pragma unroll
            for (int j = 0; j < 4; ++j) { const int c = 4 * (lane + 64 * j);
                if (sub >= 1) { const int i = sub - 1; const float gs = (i == 1) ? 1.0f : 0.5f; A[j] = (*(const f32x4*)(mr + (i * 3 + 2) * D + c) * gs) * *(const f32x4*)(a.in[9] + i * D + c); }
                if (sub <= 2) { B[j] = *(const f32x4*)(a.in[8] + sub * D + c) * (*(const f32x4*)(mr + (sub * 3 + 1) * D + c) + 1.0f); C[j] = *(const f32x4*)(mr + (sub * 3 + 0) * D + c); } } }
        f32x4 x[4];
        if (sub <= 1) { const float* xp = xrow_in(a, m);
#pragma unroll
            for (int j = 0; j < 4; ++j) x[j] = *(const f32x4*)(xp + 4 * (lane + 64 * j));
        } else {
#pragma unroll
            for (int j = 0; j < 4; ++j) { const v2u xw = *(const v2u*)(X1 + (size_t)m * D + 4 * (lane + 64 * j)); x[j] = (f32x4){__uint_as_float(xw.x << 16), __uint_as_float(xw.x & 0xffff0000u), __uint_as_float(xw.y << 16), __uint_as_float(xw.y & 0xffff0000u)}; }
        }
        if (sub >= 1) {
            f32x4 y[4]; float ss = 0.f;
#pragma unroll
            for (int j = 0; j < 4; ++j) { const v2u yw = *(const v2u*)(Y + (size_t)m * D + 4 * (lane + 64 * j)); y[j] = (f32x4){__uint_as_float(yw.x << 16), __uint_as_float(yw.x & 0xffff0000u), __uint_as_float(yw.y << 16), __uint_as_float(yw.y & 0xffff0000u)}; ss += (y[j][0] * y[j][0] + y[j][1] * y[j][1]) + (y[j][2] * y[j][2] + y[j][3] * y[j][3]); }
            const float rstd = 1.0f / sqrtf(wave_sum(ss) * (1.0f / D) + EPS);
#pragma unroll
            for (int j = 0; j < 4; ++j) { const int c = 4 * (lane + 64 * j);
                x[j] = x[j] + A[j] * (y[j] * rstd);
                if (sub == 3) *(f32x4*)(a.out + OUT_Y + (size_t)m * D + c) = x[j];
                else { v2u o; o.x = pk2(x[j][0], x[j][1]); o.y = pk2(x[j][2], x[j][3]); *(v2u*)(X1 + (size_t)m * D + c) = o; } }
        }
        if (sub <= 2) {
            float ss = 0.f;
#pragma unroll
            for (int j = 0; j < 4; ++j) ss += (x[j][0] * x[j][0] + x[j][1] * x[j][1]) + (x[j][2] * x[j][2] + x[j][3] * x[j][3]);
            const float rstd = 1.0f / sqrtf(wave_sum(ss) * (1.0f / D) + EPS);
#pragma unroll
            for (int j = 0; j < 4; ++j) { const int c = 4 * (lane + 64 * j); const f32x4 u = (x[j] * rstd) * B[j] + C[j]; v2u o; o.x = pk2(u[0], u[1]); o.y = pk2(u[2], u[3]); *(v2u*)(U + (size_t)m * D + c) = o; }
        }
    }
}
__device__ __forceinline__ float max3f(float a, float b, float c) { float r; asm("v_max3_f32 %0, %1, %2, %3" : "=v"(r) : "v"(a), "v"(b), "v"(c)); return r; }
constexpr int AT_STG = 32768;
static_assert(4 * AT_STG <= RING_BYTES && 4 * 16896 <= RING_BYTES, "attention LDS");
#define AT_WAIT_V(n) asm volatile("s_waitcnt vmcnt(" #n ")" ::: "memory")
template <bool LAT, int VAR = 0>
__device__ __forceinline__ void attn_unit(const Frame& F, const bf16* Qb, const bf16* Kp, const bf16* Vt, int ldv, int T, int qrow0, int h, float lam, const float* subg, bf16* MIX) {
    const int tid = F.tid, lane = F.lane, wid = F.wave, r = lane & 31, hh = lane >> 5, map = wid & 1;
    const int kvh = LAT ? ((wid >> 1) & 1) : 0, qb = LAT ? (wid >> 2) : (wid >> 1);
    const int qrow = qrow0 + 32 * qb + r;
    const bf16* qp = Qb + (size_t)qrow * AW + h * 128 + map * 64 + 8 * hh;
    bf16x8 qf[4];
#pragma unroll
    for (int kk = 0; kk < 4; ++kk) qf[kk] = *(const bf16x8*)(qp + 16 * kk);
    asm volatile("" : "+v"(qf[0]), "+v"(qf[1]), "+v"(qf[2]), "+v"(qf[3]));
    unsigned kgo[2], vgo[2];
#pragma unroll
    for (int i = 0; i < 2; ++i) { const int q = i * 512 + tid;
        { const int key = q >> 4, part = (q & 15) ^ (key & 15); kgo[i] = (unsigned)(key * AW + h * 128 + part * 8); }
        { const int e = q >> 3, part = (q & 7) ^ ((e >> 1) & 7); vgo[i] = (unsigned)((h * 128 + e) * ldv + part * 8); } }
    const unsigned ldsw = (unsigned)wid * 1024u;
#define AT_GLDS_K(s, slot, i_) __builtin_amdgcn_global_load_lds((const unsigned*)(Kp + (size_t)(s) * 64 * AW + kgo[i_]), (LAS unsigned*)(F.lds + (slot) * AT_STG + (i_) * 8192 + ldsw), 16, 0, 0)
#define AT_GLDS_V(s, slot, i_) __builtin_amdgcn_global_load_lds((const unsigned*)(Vt + (s) * 64 + vgo[i_]), (LAS unsigned*)(F.lds + (slot) * AT_STG + 16384 + (i_) * 8192 + ldsw), 16, 0, 0)
#define AT_STAGE(s, slot) do { AT_GLDS_K(s, slot, 0); AT_GLDS_V(s, slot, 0); AT_GLDS_K(s, slot, 1); AT_GLDS_V(s, slot, 1); } while (0)
#define AT_PIN() __builtin_amdgcn_sched_barrier(0)
    const int rp = (r & 19) | ((r & 4) << 1) | ((r & 8) >> 1);
    int kread[4], vread[2];
#pragma unroll
    for (int kk = 0; kk < 4; ++kk) kread[kk] = rp * 256 + (((map * 8 + 2 * kk + hh) ^ (rp & 15)) * 16);
#pragma unroll
    for (int s2 = 0; s2 < 2; ++s2) vread[s2] = 16384 + r * 128 + (((2 * s2 + hh) ^ ((r >> 1) & 7)) * 16);
    f32x16 acc[4];
#pragma unroll
    for (int et = 0; et < 4; ++et)
#pragma unroll
        for (int i = 0; i < 16; ++i) acc[et][i] = 0.f;
    float mrun = -INFINITY, lrun = 0.f;
    __builtin_amdgcn_s_barrier();
    __builtin_amdgcn_sched_barrier(0);
    if (VAR != 1) { AT_STAGE(0, 0); AT_STAGE((T > 1 ? 1 : T - 1), 1); AT_STAGE((T > 2 ? 2 : T - 1), 2); }
    for (int t = 0; t < T; ++t) {
        if (VAR != 1) AT_WAIT_V(8);
        __builtin_amdgcn_s_barrier();
        __builtin_amdgcn_sched_barrier(0);
        const int sn = (t + 3 < T) ? t + 3 : T - 1, sl = (t + 3) & 3;
        const LAS unsigned char* buf = F.lds + (t & 3) * AT_STG;
        if (VAR == 2) AT_STAGE(sn, sl);
#pragma unroll
        for (int jj = 0; jj < (VAR == 2 ? 0 : (LAT ? 1 : 2)); ++jj) {
            const int j = LAT ? kvh : jj;
            bf16x8 kf[4];
#pragma unroll
            for (int kk = 0; kk < 4; ++kk) kf[kk] = *(const LAS bf16x8*)(buf + kread[kk] + j * 32 * 256);
            f32x16 s;
#pragma unroll
            for (int i = 0; i < 16; ++i) s[i] = 0.f;
#pragma unroll
            for (int kk = 0; kk < 4; ++kk) s = __builtin_amdgcn_mfma_f32_32x32x16_bf16(kf[kk], qf[kk], s, 0, 0, 0);
            if (VAR != 1) { AT_PIN(); if (LAT) { AT_GLDS_K(sn, sl, 0); AT_GLDS_V(sn, sl, 0); } else if (jj == 0) AT_GLDS_K(sn, sl, 0); else AT_GLDS_K(sn, sl, 1); AT_PIN(); }
            bf16x8 vf[4][2];
#pragma unroll
            for (int et = 0; et < 4; ++et)
#pragma unroll
                for (int s2 = 0; s2 < 2; ++s2) vf[et][s2] = *(const LAS bf16x8*)(buf + (vread[s2] ^ (j * 64)) + et * 32 * 128);
            float mx = fmaxf(fmaxf(fmaxf(s[0], s[1]), fmaxf(s[2], s[3])), fmaxf(fmaxf(s[4], s[5]), fmaxf(s[6], s[7])));
            mx = fmaxf(mx, fmaxf(fmaxf(fmaxf(s[8], s[9]), fmaxf(s[10], s[11])), fmaxf(fmaxf(s[12], s[13]), fmaxf(s[14], s[15]))));
            mx = fmaxf(mx, mrun);
            const float mnew = fmaxf(mx, __shfl_xor(mx, 32));
            if (__builtin_amdgcn_ballot_w64(mnew > mrun + 8.0f) != 0ull) {
                const float alpha = __builtin_amdgcn_exp2f(mrun - mnew);
                lrun *= alpha;
#pragma unroll
                for (int et = 0; et < 4; ++et) acc[et] = acc[et] * alpha;
                mrun = mnew; }
            float ps = 0.f;
#pragma unroll
            for (int i = 0; i < 16; ++i) { s[i] = __builtin_amdgcn_exp2f(s[i] - mrun); ps += s[i]; }
            lrun += ps;
            bf16x8 pf[2];
#pragma unroll
            for (int s2 = 0; s2 < 2; ++s2) { v4u w; w.x = pk2(s[8 * s2 + 0], s[8 * s2 + 1]); w.y = pk2(s[8 * s2 + 2], s[8 * s2 + 3]); w.z = pk2(s[8 * s2 + 4], s[8 * s2 + 5]); w.w = pk2(s[8 * s2 + 6], s[8 * s2 + 7]); pf[s2] = __builtin_bit_cast(bf16x8, w); }
            if (VAR != 1) { AT_PIN(); if (LAT) { AT_GLDS_K(sn, sl, 1); AT_GLDS_V(sn, sl, 1); } else if (jj == 0) AT_GLDS_V(sn, sl, 0); else AT_GLDS_V(sn, sl, 1); AT_PIN(); }
#pragma unroll
            for (int et = 0; et < 4; ++et)
#pragma unroll
                for (int s2 = 0; s2 < 2; ++s2) acc[et] = __builtin_amdgcn_mfma_f32_32x32x16_bf16(vf[et][s2], pf[s2], acc[et], 0, 0, 0);
        }
    }
    AT_WAIT_V(0);
    __syncthreads();
    if (LAT) {
        LAS float* mb = (LAS float*)(F.lds + (qb * 2 + map) * 16896);
        if (kvh) {
#pragma unroll
            for (int et = 0; et < 4; ++et)
#pragma unroll
                for (int i = 0; i < 16; ++i) mb[(et * 16 + i) * 64 + lane] = acc[et][i];
            mb[4096 + lane] = mrun; mb[4160 + lane] = lrun; }
        __syncthreads();
        if (!kvh) { const float m1 = mb[4096 + lane], l1 = mb[4160 + lane], mt = fmaxf(mrun, m1), a0 = __builtin_amdgcn_exp2f(mrun - mt), a1 = __builtin_amdgcn_exp2f(m1 - mt);
            lrun = lrun * a0 + l1 * a1;
#pragma unroll
            for (int et = 0; et < 4; ++et)
#pragma unroll
                for (int i = 0; i < 16; ++i) acc[et][i] = acc[et][i] * a0 + mb[(et * 16 + i) * 64 + lane] * a1; }
        __syncthreads();
    }
    const float ltot = lrun + __shfl_xor(lrun, 32);
    const float inv = (map ? lam : 1.0f) / ltot;
    LAS float* xb = (LAS float*)(F.lds + qb * 16384);
    if (map && !kvh) {
#pragma unroll
        for (int et = 0; et < 4; ++et)
#pragma unroll
            for (int i = 0; i < 16; ++i) xb[(et * 16 + i) * 64 + lane] = acc[et][i] * inv;
    }
    __syncthreads();
    if (!map && !kvh) {
        f32x4 gv[4][4];
#pragma unroll
        for (int et = 0; et < 4; ++et)
#pragma unroll
            for (int g = 0; g < 4; ++g) gv[et][g] = *(const f32x4*)(subg + 32 * et + 8 * g + 4 * hh);
        float ss = 0.f;
#pragma unroll
        for (int et = 0; et < 4; ++et)
#pragma unroll
            for (int i = 0; i < 16; ++i) { const float o = acc[et][i] * inv - xb[(et * 16 + i) * 64 + lane]; acc[et][i] = o; ss += o * o; }
        ss += __shfl_xor(ss, 32);
        const float rstd = 0.8f / sqrtf(ss * (1.0f / 128.0f) + EPS);
        bf16* op = MIX + (size_t)qrow * D + h * 128 + 4 * hh;
#pragma unroll
        for (int et = 0; et < 4; ++et)
#pragma unroll
            for (int g = 0; g < 4; ++g) { const int e = 32 * et + 8 * g;
                v2u w; w.x = pk2(acc[et][4 * g + 0] * rstd * gv[et][g][0], acc[et][4 * g + 1] * rstd * gv[et][g][1]); w.y = pk2(acc[et][4 * g + 2] * rstd * gv[et][g][2], acc[et][4 * g + 3] * rstd * gv[et][g][3]);
                *(v2u*)(op + e) = w; }
    }
    asm volatile("s_waitcnt vmcnt(0)" ::: "memory");
#undef AT_STAGE
#undef AT_GLDS_K
#undef AT_GLDS_V
#undef AT_PIN
}
__device__ __forceinline__ void attn_conv_phase(const Frame& F, const Args& a, int parts) {
    unsigned char* ws = a.ws;
    const bf16* Qb = (const bf16*)(ws + WS_QB); const bf16* Kctx = (const bf16*)(ws + WS_KCTX); const bf16* Klat = (const bf16*)(ws + WS_KLAT);
    const bf16* Vtctx = (const bf16*)(ws + WS_VTCTX); const bf16* Vtlat = (const bf16*)(ws + WS_VTLAT); bf16* MIX = (bf16*)(ws + WS_MIX);
    const float* lq = a.in[16];
    const float d01 = wave_sum(lq[F.lane] * lq[64 + F.lane]), d23 = wave_sum(lq[128 + F.lane] * lq[192 + F.lane]);
    const float lam = expf(d01) - expf(d23) + 0.2f;
    const int NU = 128 + 256;
    int u = F.bx, ustep = F.G;
    if (F.G == 256 && F.bx >= 128) ustep = 128;
    for (; u < NU; u += ustep) {
        if (F.G == 256 && F.bx < 128 && u >= 128) break;
        if (u < 128 ? !(parts & 1) : !(parts & 2)) continue;
        if (u < 128) { const int bh = u & 7, b = bh >> 2, h = bh & 3, qk = u >> 3;
            if (parts & 8) attn_unit<true, 1>(F, Qb, Klat + (size_t)b * TKL * AW, Vtlat + (size_t)b * AW * TKL, TKL, TKL / 64, MC + b * TL + qk * 64, h, lam, a.in[17], (bf16*)(ws + 216 * MiB));
            else if (parts & 16) attn_unit<true, 2>(F, Qb, Klat + (size_t)b * TKL * AW, Vtlat + (size_t)b * AW * TKL, TKL, TKL / 64, MC + b * TL + qk * 64, h, lam, a.in[17], (bf16*)(ws + 216 * MiB));
            else attn_unit<true>(F, Qb, Klat + (size_t)b * TKL * AW, Vtlat + (size_t)b * AW * TKL, TKL, TKL / 64, MC + b * TL + qk * 64, h, lam, a.in[17], MIX);
        } else { const int uc = u - 128, bh = uc >> 1, b = bh >> 2, h = bh & 3, qk = uc & 1;
            attn_unit<false>(F, Qb, Kctx + (size_t)b * TC * AW, Vtctx + (size_t)b * AW * TC, TC, TC / 64, b * TC + qk * 128, h, lam, a.in[17], MIX); }
    }
    __syncthreads();
    {
        const bf16* BGb = (const bf16*)(ws + WS_BG); const bf16* Zb = (const bf16*)(ws + WS_Z); const float* cw = a.in[15];
        const int t0 = F.bx * NWAVES * 64 + F.tid, tstep = F.G * NWAVES * 64, c = (F.tid & 63) * 8;
        float w0[8], w1[8], w2[8];
#pragma unroll
        for (int j = 0; j < 8; ++j) { w0[j] = cw[c + j]; w1[j] = cw[AW + c + j]; w2[j] = cw[2 * AW + c + j]; }
        constexpr int CB = 5;
        for (int i0 = (parts & 4) ? t0 : M * 64; i0 < M * 64; i0 += CB * tstep) {
            v4u zc[CB], bgv[CB], zp[CB], zn[CB];
#pragma unroll
            for (int k = 0; k < CB; ++k) { const int i = i0 + k * tstep, m = (i < M * 64) ? (i >> 6) : 0;
                const int tl = m < MC ? (m & 255) : ((m - MC) & 1023), T = m < MC ? TC : TL;
                zc[k] = *(const v4u*)(Zb + (size_t)m * AW + c); bgv[k] = *(const v4u*)(BGb + (size_t)m * AW + c);
                zp[k] = *(const v4u*)(Zb + (size_t)(tl > 0 ? m - 1 : m) * AW + c); zn[k] = *(const v4u*)(Zb + (size_t)(tl < T - 1 ? m + 1 : m) * AW + c);
                if (tl == 0) zp[k] = (v4u){0u, 0u, 0u, 0u};
                if (tl == T - 1) zn[k] = (v4u){0u, 0u, 0u, 0u}; }
#pragma unroll
            for (int k = 0; k < CB; ++k) { const int i = i0 + k * tstep; if (i >= M * 64) break; const int m = i >> 6;
                float o[8];
#pragma unroll
                for (int j = 0; j < 8; ++j) {
                    const unsigned sh = (j & 1) * 16;
                    const float fp = __uint_as_float(((zp[k][j >> 1] >> sh) & 0xffffu) << 16), fc = __uint_as_float(((zc[k][j >> 1] >> sh) & 0xffffu) << 16), fn = __uint_as_float(((zn[k][j >> 1] >> sh) & 0xffffu) << 16);
                    const float fb = __uint_as_float(((bgv[k][j >> 1] >> sh) & 0xffffu) << 16);
                    o[j] = fb * (w0[j] * fp + w1[j] * fc + w2[j] * fn); }
                v4u w; w.x = pk2(o[0], o[1]); w.y = pk2(o[2], o[3]); w.z = pk2(o[4], o[5]); w.w = pk2(o[6], o[7]);
                *(v4u*)(MIX + (size_t)m * D + AW + c) = w; }
        }
    }
}
constexpr int NPH = 12;
__global__ void __launch_bounds__(NWAVES * 64, 2) fwd_mk(Args args) {
    extern __shared__ __attribute__((aligned(16))) unsigned char lds[];
    Frame F; F.lds = (LAS unsigned char*)lds; F.tid = threadIdx.x; F.lane = F.tid & 63; F.wave = __builtin_amdgcn_readfirstlane(F.tid >> 6); F.G = gridDim.x; F.bx = blockIdx.x;
    unsigned char* ws = args.ws;
    for (int u = F.tid; u < (LDS_BYTES - LDSCTL_OFF) / 4; u += NWAVES * 64) ((LAS unsigned*)(F.lds + LDSCTL_OFF))[u] = 0u;
    __syncthreads();
    XcdBarrier bar; bar.bar = (unsigned*)(ws + WS_CTL) + CW_BAR; bar.x = 0; bar.st = nullptr;
    if (MK_N_LAUNCHES == 1) bar = xcd_barrier_post((unsigned*)(ws + WS_CTL) + CW_BAR, (volatile LAS unsigned*)(F.lds + MISC_OFF) + 8);
    const int lo = args.ph_lo, hi = args.ph_hi;
#define IN(k) (lo <= (k) && (k) < hi)
#define SEAM(k) do { if (IN(k) && IN((k) + 1)) xcd_barrier(bar); } while (0)
#ifndef PROBE_PARTS
#define PROBE_PARTS 7
#endif
#ifndef PROBE_DUP
#define PROBE_DUP -1
#endif
#define REP(k) for (int rep_ = 0; rep_ < ((k) == PROBE_DUP ? 2 : 1); ++rep_, ((k) == PROBE_DUP && rep_ == 1 ? xcd_barrier(bar) : (void)0))
    bf16* U = (bf16*)(ws + WS_U); bf16* Gb = (bf16*)(ws + WS_G); bf16* Y = (bf16*)(ws + WS_Y);
    if (IN(0)) REP(0) { p0_prologue(F, args); } SEAM(0);
    if (IN(1)) REP(1) { row_phase(F, args, 0); } SEAM(1);
    if (IN(2)) REP(2) { pg8::Gemm g{U, (const bf16*)(ws + WS_W1U), M, NUP, D}; pg8::StaticOrder S; S.init(M, NUP, F.G, F.bx); pg8::EpiSwiGLU E{Gb, FF};
        pg8::gemm_phase<pg8::EpiSwiGLU, pg8::StaticOrder, true, true>(F.lds, g, S, E);
        { const int nwg = (M / 256) * (NUP / 256), c0 = nwg % F.G, h0 = (nwg > F.G) ? c0 : 0;
          if (F.bx >= h0) deferred_items(F, args, 0, (F.bx - h0) * NWAVES + F.wave, (F.G - h0) * NWAVES); } } SEAM(2);
    if (IN(3)) REP(3) { pg8::Gemm g{Gb, (const bf16*)(ws + WS_W1D), M, D, FF}; pg8::StaticOrder S; S.init(M, D, F.G, F.bx); pg8::EpiY E{Y, D};
        pg8::gemm_phase<pg8::EpiY, pg8::StaticOrder, true, true>(F.lds, g, S, E);
        { const int nwg = (M / 256) * (D / 256), h0 = F.G > nwg ? nwg : 0;
          if (F.bx >= h0) deferred_items(F, args, 1, (F.bx - h0) * NWAVES + F.wave, (F.G - h0) * NWAVES); } } SEAM(3);
    if (IN(4)) REP(4) { row_phase(F, args, 1); } SEAM(4);
    if (IN(5)) REP(5) { pg8::Gemm g{U, (const bf16*)(ws + WS_WIN), M, NIN, D}; pg8::StaticOrder S; S.init(M, NIN, F.G, F.bx);
        pg8::EpiMix E{(bf16*)(ws + WS_QB), (bf16*)(ws + WS_KCTX), (bf16*)(ws + WS_KLAT), (bf16*)(ws + WS_VTCTX), (bf16*)(ws + WS_VTLAT), (bf16*)(ws + WS_BG), (bf16*)(ws + WS_Z),
                      args.out + OUT_NK, args.out + OUT_NV, (const float*)(ws + WS_MISC + 128 * 1024), (const float*)(ws + WS_MISC + 128 * 1024) + 1024};
        pg8::gemm_phase<pg8::EpiMix, pg8::StaticOrder, true, true>(F.lds, g, S, E); } SEAM(5);
    if (IN(6)) REP(6) { attn_conv_phase(F, args, 7); } SEAM(6);
    if (IN(7)) REP(7) { pg8::Gemm g{(const bf16*)(ws + WS_MIX), (const bf16*)(ws + WS_WO), M, D, D}; pg8::StaticOrder S; S.init(M, D, F.G, F.bx); pg8::EpiY E{Y, D};
        pg8::gemm_phase<pg8::EpiY, pg8::StaticOrder, true, true>(F.lds, g, S, E); } SEAM(7);
    if (IN(8)) REP(8) { row_phase(F, args, 2); } SEAM(8);
    if (IN(9)) REP(9) { pg8::Gemm g{U, (const bf16*)(ws + WS_W2U), M, NUP, D}; pg8::StaticOrder S; S.init(M, NUP, F.G, F.bx); pg8::EpiSwiGLU E{Gb, FF};
        pg8::gemm_phase<pg8::EpiSwiGLU, pg8::StaticOrder, true, true>(F.lds, g, S, E); } SEAM(9);
    if (IN(10)) REP(10) { pg8::Gemm g{Gb, (const bf16*)(ws + WS_W2D), M, D, FF}; pg8::StaticOrder S; S.init(M, D, F.G, F.bx); pg8::EpiY E{Y, D};
        pg8::gemm_phase<pg8::EpiY, pg8::StaticOrder, true, true>(F.lds, g, S, E); } SEAM(10);
    if (IN(11)) REP(11) { row_phase(F, args, 3); }
#undef IN
#undef SEAM
}

extern "C" void kernel_launch(void* const* d_in, const int* in_sizes, int n_in, void* d_out, int out_size, void* d_ws, size_t ws_size, hipStream_t stream) {
    static int grid = 0;
    if (grid == 0) {
        if (n_in != 19 || ws_size < WS_END) { fprintf(stderr, "kernel_launch: unexpected n_in %d / ws %zu\n", n_in, ws_size); grid = -1; return; }
        int dev = 0, cus = 0, per_cu = 0;
        if (hipGetDevice(&dev) != hipSuccess || hipDeviceGetAttribute(&cus, hipDeviceAttributeMultiprocessorCount, dev) != hipSuccess) { grid = -1; return; }
        if (hipFuncSetAttribute((const void*)fwd_mk, hipFuncAttributeMaxDynamicSharedMemorySize, LDS_BYTES) != hipSuccess) { fprintf(stderr, "kernel_launch: hipFuncSetAttribute failed\n"); grid = -1; return; }
        if (hipOccupancyMaxActiveBlocksPerMultiprocessor(&per_cu, (const void*)fwd_mk, NWAVES * 64, LDS_BYTES) != hipSuccess || per_cu < 1) fprintf(stderr, "kernel_launch: occupancy query says %d\n", per_cu);
        (void)hipGetLastError();
        grid = cus;
    }
    if (grid < 0) return;
    (void)hipMemsetAsync((char*)d_ws + WS_CTL, 0, CTL_ZERO_BYTES, stream);
    Args a{};
    for (int i = 0; i < 19; ++i) a.in[i] = (const float*)d_in[i];
    a.out = (float*)d_out; a.ws = (unsigned char*)d_ws;
#if MK_N_LAUNCHES == 1
    a.ph_lo = 0; a.ph_hi = NPH; a.li = 0;
    void* kargs[] = {&a};
    hipError_t e = hipLaunchCooperativeKernel((const void*)fwd_mk, dim3(grid), dim3(NWAVES * 64), kargs, LDS_BYTES, stream);
    if (e != hipSuccess) fprintf(stderr, "kernel_launch: cooperative launch failed: %s (grid %d)\n", hipGetErrorString(e), grid);
#else
    for (int li = 0; li < NPH; ++li) { a.ph_lo = li; a.ph_hi = li + 1; a.li = li; hipLaunchKernelGGL(fwd_mk, dim3(grid), dim3(NWAVES * 64), LDS_BYTES, stream, a); }
#endif
}
```

```cpp
#include <hip/hip_runtime.h>
#include <hip/hip_cooperative_groups.h>
#include <cstdio>
#include <cstdint>
#ifndef MK_N_LAUNCHES
#define MK_N_LAUNCHES 1
#endif
namespace pg8 {
#define PG8_LAS __attribute__((address_space(3)))
typedef unsigned short bf16_t;
typedef short bf16x8 __attribute__((ext_vector_type(8)));
typedef float f32x4 __attribute__((ext_vector_type(4)));
typedef unsigned u32x4 __attribute__((ext_vector_type(4)));
constexpr int BM = 256, BK = 64, HALF = 128, HTB = HALF * BK * 2  , STAGE_BYTES = 8 * HTB, NXCD = 8, WGM = 8;

__host__ __device__ __forceinline__ int lds_byte(int r, int c) { const int st = (r >> 4) * 2 + (c >> 5), rr = r & 15, cc = c & 31, ob = rr * 64 + cc * 2; return st * 1024 + (ob ^ (((ob >> 9) & 1) << 5)); }
__host__ __device__ __forceinline__ void stage_rc(int b, int& R, int& C) { const int st = b / 1024, sb = b % 1024, swz = sb ^ (((sb >> 9) & 1) << 5); R = (st >> 1) * 16 + swz / 64; C = (st & 1) * 32 + (swz % 64) / 2; }
__host__ __device__ __forceinline__ int perm32(int rho) { const int n = rho >> 4, i = rho & 15; return 8 * (i >> 2) + 4 * n + (i & 3); }

struct Unit { int pm, pn, half; };
struct Gemm { const bf16_t* A; const bf16_t* Bt; int M, N, K; };

struct StaticOrder {
    int nM, nN, nwg, G, c;
    __host__ __device__ void init(int M, int N, int G_, int c_) { nM = M / BM; nN = N / BM; nwg = nM * nN; G = G_; c = c_; }
    __host__ __device__ bool next(int i, Unit& u) const {
        const long L = (long)i * G + c; if (L >= nwg) return false;
        int wgid = (int)L; { const int q = nwg / NXCD, r = nwg % NXCD, xcd = wgid % NXCD, off = wgid / NXCD; wgid = (xcd < r ? xcd * (q + 1) : r * (q + 1) + (xcd - r) * q) + off; }
        const int nig = WGM * nN, gid = wgid / nig, fm = gid * WGM, gsz = (nM - fm) < WGM ? (nM - fm) : WGM;
        u.pm = fm + ((wgid % nig) % gsz); u.pn = (wgid % nig) / gsz; u.half = 0; return true;
    }
    __device__ __forceinline__ void a_ready(const Unit&) const {}
    __device__ __forceinline__ void done(const Unit&) const {}
};
struct TailSplitOrder {
    int nM, nN, nwg, G, c, nfull, nitems;
    __host__ __device__ void init(int M, int N, int G_, int c_) { nM = M / BM; nN = N / BM; nwg = nM * nN; G = G_; c = c_; nfull = (nwg / G) * G; const int rem = nwg - nfull;
        if (2 * rem > G) { nfull = nwg; } nitems = nfull + 2 * (nwg - nfull); }
    __host__ __device__ bool next(int i, Unit& u) const {
        const long L = (long)i * G + c; if (L >= nitems) return false;
        int wgid, half; if (L < nfull) { wgid = (int)L; half = 0; } else { wgid = nfull + (int)(L - nfull) / 2; half = 1 + (int)((L - nfull) & 1); }
        { const int q = nwg / NXCD, r = nwg % NXCD, xcd = wgid % NXCD, off = wgid / NXCD; wgid = (xcd < r ? xcd * (q + 1) : r * (q + 1) + (xcd - r) * q) + off; }
        const int nig = WGM * nN, gid = wgid / nig, fm = gid * WGM, gsz = (nM - fm) < WGM ? (nM - fm) : WGM;
        u.pm = fm + ((wgid % nig) % gsz); u.pn = (wgid % nig) / gsz; u.half = half; return true;
    }
    __device__ __forceinline__ void a_ready(const Unit&) const {}
    __device__ __forceinline__ void done(const Unit&) const {}
};
typedef float f32x2c __attribute__((ext_vector_type(2))); typedef __bf16 bf16x2c __attribute__((ext_vector_type(2)));
__device__ __forceinline__ unsigned cvt_pk_bf16(float lo, float hi) { const f32x2c v = {lo, hi}; const bf16x2c b = __builtin_convertvector(v, bf16x2c); return __builtin_bit_cast(unsigned, b); }
typedef float f32x2 __attribute__((ext_vector_type(2)));
typedef unsigned u32x2 __attribute__((ext_vector_type(2)));
__device__ __forceinline__ f32x4 silu_mul(f32x4 a, f32x4 b) {
    f32x4 o;
#pragma unroll
    for (int j = 0; j < 4; ++j) { const float e = __builtin_amdgcn_exp2f(a[j] * -1.4426950408889634f); o[j] = a[j] * b[j] * __builtin_amdgcn_rcpf(1.0f + e); }
    return o;
}
struct EpiSwiGLU {
    static constexpr bool PERM = false, AFTER_DRAIN = false;
    bf16_t* G; int ldg;
    __device__ __forceinline__ void operator()(const f32x4 (&acc)[2][2][4][2], const Unit& u, int wr, int wc, int fr, int fq) const {
        const int row0 = u.pm * BM + wr * 64 + fr, col0 = u.pn * HALF + wc * 32 + 8 * fq;
#pragma unroll
        for (int ai = 0; ai < 2; ++ai) { if (u.half && u.half != ai + 1) continue;
#pragma unroll
            for (int m = 0; m < 4; ++m) {
                const f32x4 g0 = silu_mul(acc[ai][0][m][0], acc[ai][1][m][0]), g1 = silu_mul(acc[ai][0][m][1], acc[ai][1][m][1]);
                u32x4 w; w.x = cvt_pk_bf16(g0[0], g0[1]); w.y = cvt_pk_bf16(g0[2], g0[3]); w.z = cvt_pk_bf16(g1[0], g1[1]); w.w = cvt_pk_bf16(g1[2], g1[3]);
                *(u32x4*)(G + (size_t)(row0 + ai * HALF + m * 16) * ldg + col0) = w; } }
    }
};
struct EpiY {
    static constexpr bool PERM = false, AFTER_DRAIN = false;
    bf16_t* C; int ldc;
    __device__ __forceinline__ void operator()(const f32x4 (&acc)[2][2][4][2], const Unit& u, int wr, int wc, int fr, int fq) const {
        const int row0 = u.pm * BM + wr * 64 + fr, col0 = u.pn * BM + wc * 32 + 8 * fq;
#pragma unroll
        for (int ai = 0; ai < 2; ++ai)
#pragma unroll
            for (int m = 0; m < 4; ++m) { bf16_t* rowp = C + (size_t)(row0 + ai * HALF + m * 16) * ldc + col0;
#pragma unroll
                for (int bj = 0; bj < 2; ++bj) { const f32x4 v0 = acc[ai][bj][m][0], v1 = acc[ai][bj][m][1];
                    u32x4 w; w.x = cvt_pk_bf16(v0[0], v0[1]); w.y = cvt_pk_bf16(v0[2], v0[3]); w.z = cvt_pk_bf16(v1[0], v1[1]); w.w = cvt_pk_bf16(v1[2], v1[3]); *(u32x4*)(rowp + bj * HALF) = w; } }
    }
};
struct EpiMix {
    static constexpr bool PERM = false, AFTER_DRAIN = false;
    bf16_t *Qb, *Kctx, *Klat, *Vtctx, *Vtlat, *BGb, *Zb; float *newk, *newv; const float *ropeC, *ropeS;
    __device__ __forceinline__ void operator()(const f32x4 (&acc)[2][2][4][2], const Unit& u, int wr, int wc, int fr, int fq) const {
        const int pn = u.pn, pm = u.pm; const bool lat = pm >= 32;
        const int lb = (pm - 32) >> 2, lt0 = ((pm - 32) & 3) * 256;
        const float C2 = 0.125f * 1.4426950408889634f;
        if (pn < 4) {
            const bool isk = pn >= 2; const int colbase = (pn & 1) * 256 + wc * 32 + 4 * fq;
#pragma unroll
            for (int ai = 0; ai < 2; ++ai)
#pragma unroll
                for (int m = 0; m < 4; ++m) {
                    const int rl = wr * 64 + fr + ai * HALF + m * 16, R = pm * BM + rl, t = lt0 + rl;
                    f32x4 c4 = {1.f, 1.f, 1.f, 1.f}, s4 = {0.f, 0.f, 0.f, 0.f};
                    if (lat) { const int pos = (wc & 1) ? (t & 63) : (t >> 6); c4 = *(const f32x4*)(ropeC + pos * 16 + 4 * fq); s4 = *(const f32x4*)(ropeS + pos * 16 + 4 * fq); }
                    bf16_t* dst = !isk ? Qb + (size_t)R * 512 : (lat ? Klat + (size_t)(lb * 1536 + 512 + t) * 512 : Kctx + (size_t)R * 512);
#pragma unroll
                    for (int bj = 0; bj < 2; ++bj) {
                        f32x4 x1 = acc[ai][bj][m][0], x2 = acc[ai][bj][m][1];
                        const int col = colbase + bj * HALF;
                        if (isk && !lat) { *(f32x4*)(newk + (size_t)R * 512 + col) = x1; *(f32x4*)(newk + (size_t)R * 512 + col + 16) = x2; }
                        const f32x4 y1 = x1 * c4 - x2 * s4, y2 = x2 * c4 + x1 * s4; x1 = y1; x2 = y2;
                        if (!isk) { x1 = x1 * C2; x2 = x2 * C2; }
                        u32x4 w; w.x = cvt_pk_bf16(x1[0], x1[1]); w.y = cvt_pk_bf16(x1[2], x1[3]); w.z = cvt_pk_bf16(x2[0], x2[1]); w.w = cvt_pk_bf16(x2[2], x2[3]);
                        *(u32x4*)(dst + (pn & 1) * 256 + bj * HALF + wc * 32 + 8 * fq) = w; } }
        } else if (pn < 6) {
            const int colbase = (pn - 4) * 256 + wc * 32 + 4 * fq;
#pragma unroll
            for (int ai = 0; ai < 2; ++ai)
#pragma unroll
                for (int m = 0; m < 4; ++m) {
                    const int rl = wr * 64 + fr + ai * HALF + m * 16, R = pm * BM + rl, t = lt0 + rl;
                    bf16_t* vt = lat ? Vtlat + (size_t)(lb * 512) * 1536 + 512 + t : Vtctx + (size_t)(pm * 512) * 256 + rl;
                    const size_t ldv = lat ? 1536 : 256;
#pragma unroll
                    for (int bj = 0; bj < 2; ++bj)
#pragma unroll
                        for (int n = 0; n < 2; ++n) { const f32x4 v = acc[ai][bj][m][n]; const int col = colbase + bj * HALF + n * 16;
                            if (!lat) *(f32x4*)(newv + (size_t)R * 512 + col) = v;
                            const unsigned p01 = cvt_pk_bf16(v[0], v[1]), p23 = cvt_pk_bf16(v[2], v[3]);
                            vt[(size_t)(col + 0) * ldv] = (bf16_t)(p01 & 0xffffu); vt[(size_t)(col + 1) * ldv] = (bf16_t)(p01 >> 16);
                            vt[(size_t)(col + 2) * ldv] = (bf16_t)(p23 & 0xffffu); vt[(size_t)(col + 3) * ldv] = (bf16_t)(p23 >> 16); } }
        } else if (pn < 8) {
            const int colbase = (pn - 6) * 256 + wc * 32 + 8 * fq;
#pragma unroll
            for (int ai = 0; ai < 2; ++ai)
#pragma unroll
                for (int m = 0; m < 4; ++m) { bf16_t* dst = BGb + (size_t)(pm * BM + wr * 64 + fr + ai * HALF + m * 16) * 512 + colbase;
#pragma unroll
                    for (int bj = 0; bj < 2; ++bj) { const f32x4 v0 = acc[ai][bj][m][0], v1 = acc[ai][bj][m][1];
                        u32x4 w; w.x = cvt_pk_bf16(v0[0], v0[1]); w.y = cvt_pk_bf16(v0[2], v0[3]); w.z = cvt_pk_bf16(v1[0], v1[1]); w.w = cvt_pk_bf16(v1[2], v1[3]); *(u32x4*)(dst + bj * HALF) = w; } }
        } else {
            const int col0 = (pn - 8) * HALF + wc * 32 + 8 * fq;
#pragma unroll
            for (int ai = 0; ai < 2; ++ai)
#pragma unroll
                for (int m = 0; m < 4; ++m) { const f32x4 z0 = acc[ai][0][m][0] * acc[ai][1][m][0], z1 = acc[ai][0][m][1] * acc[ai][1][m][1];
                    u32x4 w; w.x = cvt_pk_bf16(z0[0], z0[1]); w.y = cvt_pk_bf16(z0[2], z0[3]); w.z = cvt_pk_bf16(z1[0], z1[1]); w.w = cvt_pk_bf16(z1[2], z1[3]);
                    *(u32x4*)(Zb + (size_t)(pm * BM + wr * 64 + fr + ai * HALF + m * 16) * 512 + col0) = w; }
        }
    }
};
template <class Epi, class Sched, bool ALIGN_EPI = false, bool SP2 = false, bool HALFABLE = false>
__device__ __forceinline__ void gemm_phase(PG8_LAS unsigned char* lds, const Gemm g, const Sched& S, const Epi& E) {
    const int tid = threadIdx.x, wid = __builtin_amdgcn_readfirstlane(tid >> 6), lane = tid & 63, wr = wid >> 2, wc = wid & 3, fr = lane & 15, fq = lane >> 4;
    const int K = g.K, nt = K / BK;
    unsigned voffA[2], voffB[2];
#pragma unroll
    for (int i = 0; i < 2; ++i) { int R, C; stage_rc(tid * 16 + i * 8192, R, C); const int Rb = Epi::PERM ? ((R & ~31) + perm32(R & 31)) : R;
        voffA[i] = (unsigned)(R * K + C) * 2u; voffB[i] = (unsigned)(Rb * K + C) * 2u; }
    const size_t kstep = (size_t)(BK * 2);
    const size_t hstep = (size_t)HALF * K * 2;
    const size_t tstep = 2 * hstep;
    const unsigned ldsw = (unsigned)wid * 1024u;
    const int aoff = lds_byte(wr * 64 + fr, fq * 8), boff = lds_byte(wc * 32 + fr, fq * 8);
#define PG8_SA(b, h) (((b) * 2 + (h)) * HTB)
#define PG8_SB(b, h) ((4 + (b) * 2 + (h)) * HTB)
#define PG8_STAGE(bufoff, gbase, voff) do { _Pragma("unroll") for (int _i = 0; _i < 2; ++_i) \
        __builtin_amdgcn_global_load_lds((const unsigned*)((const char*)(gbase) + (voff)[_i]), (PG8_LAS unsigned*)(lds + (bufoff) + ldsw + _i * 8192), 16, 0, 0); } while (0)
#define PG8_LDA(dst, b, h) do { _Pragma("unroll") for (int m = 0; m < 4; ++m) _Pragma("unroll") for (int k = 0; k < 2; ++k) dst[m][k] = *(const PG8_LAS bf16x8*)(lds + PG8_SA(b, h) + aoff + m * 2048 + k * 1024); } while (0)
#define PG8_LDB(dst, b, h) do { _Pragma("unroll") for (int n = 0; n < 2; ++n) _Pragma("unroll") for (int k = 0; k < 2; ++k) dst[n][k] = *(const PG8_LAS bf16x8*)(lds + PG8_SB(b, h) + boff + n * 2048 + k * 1024); } while (0)
#define PG8_MMA(ai, bj, At, Bt) do { __builtin_amdgcn_s_setprio(1); _Pragma("unroll") for (int m = 0; m < 4; ++m) _Pragma("unroll") for (int n = 0; n < 2; ++n) _Pragma("unroll") for (int k = 0; k < 2; ++k) \
        acc[ai][bj][m][n] = __builtin_amdgcn_mfma_f32_16x16x32_bf16(Bt[n][k], At[m][k], acc[ai][bj][m][n], 0, 0, 0); __builtin_amdgcn_s_setprio(0); } while (0)
#define PG8_WAIT_V(n) asm volatile("s_waitcnt vmcnt(" #n ")" ::: "memory")
#define PG8_WAIT_L(n) asm volatile("s_waitcnt lgkmcnt(" #n ")" ::: "memory")
#define PG8_BAR __builtin_amdgcn_s_barrier()
#define PG8_SCHED __builtin_amdgcn_sched_barrier(0)
    Unit cur, nxt; int ui = 0;
    if (!S.next(0, cur)) return;
    f32x4 acc[2][2][4][2];
#pragma unroll
    for (int a = 0; a < 2; ++a)
#pragma unroll
        for (int b = 0; b < 2; ++b)
#pragma unroll
            for (int m = 0; m < 4; ++m)
#pragma unroll
                for (int n = 0; n < 2; ++n) acc[a][b][m][n] = (f32x4){0.f, 0.f, 0.f, 0.f};
    bf16x8 At[4][2], B0[2][2], B1[2][2];
    const char* cA = (const char*)g.A + (size_t)cur.pm * tstep; const char* cB = (const char*)g.Bt + (size_t)cur.pn * tstep;
    S.a_ready(cur);
    if constexpr (SP2) {
        PG8_STAGE(PG8_SB(0, 0), cB, voffB); PG8_STAGE(PG8_SB(0, 1), cB + hstep, voffB); PG8_STAGE(PG8_SA(0, 0), cA, voffA); PG8_STAGE(PG8_SA(0, 1), cA + hstep, voffA);
        if (wr == 1) PG8_BAR;
        PG8_WAIT_V(2); PG8_BAR;
        PG8_STAGE(PG8_SB(1, 0), cB + kstep, voffB); PG8_STAGE(PG8_SA(1, 0), cA + kstep, voffA); PG8_STAGE(PG8_SB(1, 1), cB + hstep + kstep, voffB);
        PG8_WAIT_V(6); PG8_BAR;
    } else {
        PG8_STAGE(PG8_SB(0, 0), cB, voffB); PG8_STAGE(PG8_SA(0, 0), cA, voffA); PG8_STAGE(PG8_SB(0, 1), cB + hstep, voffB); PG8_STAGE(PG8_SA(0, 1), cA + hstep, voffA);
        if (wr == 1) PG8_BAR;
        PG8_WAIT_V(4); PG8_BAR;
        PG8_STAGE(PG8_SB(1, 0), cB + kstep, voffB); PG8_STAGE(PG8_SA(1, 0), cA + kstep, voffA); PG8_STAGE(PG8_SB(1, 1), cB + hstep + kstep, voffB);
        PG8_WAIT_V(6); PG8_BAR;
    }
    for (;;) {
        const bool has_next = S.next(ui + 1, nxt);
        const bool do0 = !HALFABLE || cur.half != 2, do1 = !HALFABLE || cur.half != 1;
        const char* nA = has_next ? (const char*)g.A + (size_t)nxt.pm * tstep : cA; const char* nB = has_next ? (const char*)g.Bt + (size_t)nxt.pn * tstep : cB;
        for (int t = 0; t < nt; t += 2) {
            const bool last = (t == nt - 2);
            const char* a1 = cA + (size_t)(t + 1) * kstep;
            const char* a2 = last ? nA : cA + (size_t)(t + 2) * kstep; const char* b2 = last ? nB : cB + (size_t)(t + 2) * kstep;
            const char* a3 = a2 + kstep; const char* b3 = b2 + kstep;
            if (last && has_next) S.a_ready(nxt);
            if constexpr (SP2) {
            PG8_LDB(B0, 0, 0); PG8_LDB(B1, 0, 1); PG8_SCHED; if (do0) PG8_LDA(At, 0, 0); PG8_STAGE(PG8_SA(1, 1), a1 + hstep, voffA);
            PG8_WAIT_V(8); PG8_WAIT_L(0); PG8_BAR; if (do0) { PG8_MMA(0, 0, At, B0); PG8_MMA(0, 1, At, B1); } PG8_BAR; PG8_SCHED;
            if (do1) PG8_LDA(At, 0, 1); PG8_STAGE(PG8_SB(0, 0), b2, voffB); PG8_STAGE(PG8_SB(0, 1), b2 + hstep, voffB); PG8_STAGE(PG8_SA(0, 0), a2, voffA);
            PG8_WAIT_V(8); PG8_WAIT_L(0); PG8_BAR; if (do1) { PG8_MMA(1, 0, At, B0); PG8_MMA(1, 1, At, B1); } PG8_BAR; PG8_SCHED;
            PG8_LDB(B0, 1, 0); PG8_LDB(B1, 1, 1); PG8_SCHED; if (do0) PG8_LDA(At, 1, 0); PG8_STAGE(PG8_SA(0, 1), a2 + hstep, voffA);
            PG8_WAIT_V(8); PG8_WAIT_L(0); PG8_BAR; if (do0) { PG8_MMA(0, 0, At, B0); PG8_MMA(0, 1, At, B1); } PG8_BAR; PG8_SCHED;
            if (do1) PG8_LDA(At, 1, 1); PG8_STAGE(PG8_SB(1, 0), b3, voffB); PG8_STAGE(PG8_SB(1, 1), b3 + hstep, voffB); PG8_STAGE(PG8_SA(1, 0), a3, voffA);
            PG8_WAIT_V(8); PG8_WAIT_L(0); PG8_BAR; if (do1) { PG8_MMA(1, 0, At, B0); PG8_MMA(1, 1, At, B1); } PG8_BAR; PG8_SCHED;
            } else {
            PG8_LDB(B0, 0, 0); PG8_SCHED; PG8_LDA(At, 0, 0); PG8_STAGE(PG8_SA(1, 1), a1 + hstep, voffA);
            PG8_WAIT_L(8); PG8_BAR; PG8_WAIT_L(0); PG8_MMA(0, 0, At, B0); PG8_BAR; PG8_SCHED;
            PG8_LDB(B1, 0, 1); PG8_STAGE(PG8_SB(0, 0), b2, voffB);
            PG8_BAR; PG8_WAIT_L(0); PG8_MMA(0, 1, At, B1); PG8_BAR;
            PG8_LDA(At, 0, 1); PG8_STAGE(PG8_SA(0, 0), a2, voffA);
            PG8_BAR; PG8_WAIT_L(0); PG8_MMA(1, 0, At, B0); PG8_BAR; PG8_SCHED;
            PG8_STAGE(PG8_SB(0, 1), b2 + hstep, voffB);
            PG8_WAIT_V(6); PG8_BAR; PG8_MMA(1, 1, At, B1); PG8_BAR;
            PG8_LDB(B0, 1, 0); PG8_SCHED; PG8_LDA(At, 1, 0); PG8_STAGE(PG8_SA(0, 1), a2 + hstep, voffA);
            PG8_WAIT_L(8); PG8_BAR; PG8_WAIT_L(0); PG8_MMA(0, 0, At, B0); PG8_BAR; PG8_SCHED;
            PG8_LDB(B1, 1, 1); PG8_STAGE(PG8_SB(1, 0), b3, voffB);
            PG8_BAR; PG8_WAIT_L(0); PG8_MMA(0, 1, At, B1); PG8_BAR;
            PG8_LDA(At, 1, 1); PG8_STAGE(PG8_SA(1, 0), a3, voffA);
            PG8_BAR; PG8_WAIT_L(0); PG8_MMA(1, 0, At, B0); PG8_BAR; PG8_SCHED;
            PG8_STAGE(PG8_SB(1, 1), b3 + hstep, voffB);
            PG8_WAIT_V(6); PG8_BAR; PG8_MMA(1, 1, At, B1); PG8_BAR;
            }
        }
        if constexpr (ALIGN_EPI) { if (wr == 0) PG8_BAR; }
        if constexpr (!Epi::AFTER_DRAIN) { E(acc, cur, wr, wc, fr, fq); S.done(cur); }
        if (!has_next) break;
#pragma unroll
        for (int a = 0; a < 2; ++a)
#pragma unroll
            for (int b = 0; b < 2; ++b)
#pragma unroll
                for (int m = 0; m < 4; ++m)
#pragma unroll
                    for (int n = 0; n < 2; ++n) acc[a][b][m][n] = (f32x4){0.f, 0.f, 0.f, 0.f};
        cur = nxt; cA = nA; cB = nB; ++ui;
        if constexpr (ALIGN_EPI) { if (wr == 1) PG8_BAR; }
    }
    PG8_WAIT_V(0);
    if constexpr (!ALIGN_EPI) { if (wr == 0) PG8_BAR; }
    PG8_BAR;
    if constexpr (Epi::AFTER_DRAIN) { E.fused(acc, cur, wr, wc, fr, fq, lds, wid, lane); S.done(cur); }
#undef PG8_SA
#undef PG8_SB
#undef PG8_STAGE
#undef PG8_LDA
#undef PG8_LDB
#undef PG8_MMA
#undef PG8_WAIT_V
#undef PG8_WAIT_L
#undef PG8_BAR
#undef PG8_SCHED
}
}
constexpr int NWAVES = 8;
constexpr int D = 1024, MC = 8192, MLAT = 2048, M = MC + MLAT, FF = 2816, NUP = 2 * FF, NIN = 3072, AW = 512;
constexpr int TC = 256, TL = 1024, PAST = 512, TKL = PAST + TL, NMODC = 9 * D;
constexpr float EPS = 1e-6f;
constexpr size_t OUT_Y = 0, OUT_NK = (size_t)M * D, OUT_NV = OUT_NK + (size_t)MC * AW;
constexpr size_t MiB = 1u << 20, HMiB = 1u << 19;
constexpr size_t WS_CTL = 0, CTL_ZERO_BYTES = 64 * 1024;
constexpr size_t WS_MISC = 1 * MiB;
constexpr size_t WS_W1U = 2 * MiB, WS_W1D = 13 * MiB, WS_W2U = 13 * MiB + 11 * HMiB, WS_W2D = WS_W2U + 11 * MiB, WS_WIN = 35 * MiB, WS_WO = 41 * MiB;
constexpr size_t WS_KLAT = 43 * MiB, WS_VTLAT = 46 * MiB, WS_U = 49 * MiB, WS_Y = 69 * MiB, WS_X1 = 109 * MiB, WS_R = 149 * MiB;
constexpr size_t WS_G = WS_R, WS_QB = WS_R, WS_KCTX = WS_R + 10 * MiB, WS_VTCTX = WS_R + 18 * MiB, WS_BG = WS_R + 26 * MiB, WS_Z = WS_R + 36 * MiB, WS_MIX = WS_R + 46 * MiB;
constexpr size_t WS_END = WS_R + 66 * MiB;
static_assert(WS_W2D + 11 * HMiB == WS_WIN && WS_G + (size_t)M * FF * 2 <= WS_END && WS_END <= 256 * MiB, "ws map");
constexpr int CW_BAR = 1024;
constexpr int RING_BYTES = 131072, LDSCTL_OFF = RING_BYTES, MISC_OFF = LDSCTL_OFF + 320, LDS_BYTES = 147456;

#define GAS __attribute__((address_space(1)))
#define LAS __attribute__((address_space(3)))
typedef unsigned short bf16;
typedef unsigned v4u __attribute__((ext_vector_type(4)));
typedef unsigned v2u __attribute__((ext_vector_type(2)));
typedef float f32x4 __attribute__((ext_vector_type(4)));
typedef float f32x16 __attribute__((ext_vector_type(16)));
typedef short bf16x8 __attribute__((ext_vector_type(8)));
typedef short s16x4 __attribute__((ext_vector_type(4)));
#define LDS_WAIT() asm volatile("s_waitcnt lgkmcnt(0)" ::: "memory")
__device__ __forceinline__ unsigned f2bf(float f) { unsigned u = __builtin_bit_cast(unsigned, f); return (u + 0x7fffu + ((u >> 16) & 1u)) >> 16; }
typedef float f32x2_t __attribute__((ext_vector_type(2)));
typedef __bf16 bf16x2_t __attribute__((ext_vector_type(2)));
__device__ __forceinline__ unsigned pk2(float lo, float hi) { const f32x2_t v = {lo, hi}; const bf16x2_t b = __builtin_convertvector(v, bf16x2_t); return __builtin_bit_cast(unsigned, b); }
#define XB_TMO      128
#define XB_XCNT(j)  (256  + 64 * (j))
#define XB_XSUB(j)  (1280 + 64 * (j))
#define XB_XGEN(j)  (2304 + 64 * (j))
#define XB_TOP      3328
#define XB_TOPGEN   3392
#define XCD_BAR_WORDS 3456
#define XB_SPIN_CAP (1u << 18)

__device__ __forceinline__ unsigned xb_ld(unsigned* p)              { return __hip_atomic_load(p, __ATOMIC_RELAXED, __HIP_MEMORY_SCOPE_AGENT); }
__device__ __forceinline__ unsigned xb_add(unsigned* p, unsigned v) { return __hip_atomic_fetch_add(p, v, __ATOMIC_RELAXED, __HIP_MEMORY_SCOPE_AGENT); }
__device__ __forceinline__ unsigned xb_xcc_id() { return (unsigned)__builtin_amdgcn_s_getreg((3 << 11) | 20) & 0xFu; }
#define XB_SPIN(cond, bar) do { unsigned _sp = 0; while (cond) { __builtin_amdgcn_s_sleep(1); \
    if ((++_sp & 255u) == 0u) { if (xb_ld(&(bar)[XB_TMO])) break; if (_sp > XB_SPIN_CAP) { atomicAdd(&(bar)[XB_TMO], 1u); break; } } } } while (0)

struct XcdBarrier {
    unsigned* bar; unsigned x;
    volatile LAS unsigned* st;
};

__device__ __forceinline__ XcdBarrier xcd_barrier_post(unsigned* bar, volatile LAS unsigned* st) {
    XcdBarrier b; b.bar = bar; b.x = xb_xcc_id(); b.st = st;
    if (threadIdx.x == 0) (void)xb_add(&bar[XB_XCNT(b.x)], 1u);
    return b;
}
__device__ __forceinline__ void xcd_barrier_complete(unsigned* bar, unsigned x, unsigned& nloc, unsigned& nx) {
    const unsigned G = gridDim.x * gridDim.y * gridDim.z;
    unsigned sum, cnt, mine, sp = 0u;
    for (;;) {
        sum = 0u; cnt = 0u; mine = 0u;
#pragma unroll
        for (unsigned j = 0; j < 16; ++j) { const unsigned c = xb_ld(&bar[XB_XCNT(j)]); sum += c; cnt += (c > 0u) ? 1u : 0u; mine = (j == x) ? c : mine; }
        if (sum == G) break;
        __builtin_amdgcn_s_sleep(1);
        if ((++sp & 255u) == 0u) { if (xb_ld(&bar[XB_TMO])) break; if (sp > XB_SPIN_CAP) { atomicAdd(&bar[XB_TMO], 1u); break; } }
    }
    nloc = mine > 0u ? mine : 1u; nx = cnt > 0u ? cnt : 1u;
}

__device__ __forceinline__ void xcd_barrier(const XcdBarrier& b) {
    asm volatile("s_waitcnt vmcnt(0)" ::: "memory");
    __syncthreads();
    if (threadIdx.x == 0) {
        unsigned* bar = b.bar;
        __builtin_amdgcn_s_waitcnt(0);
        unsigned nloc = b.st[0], nx = b.st[1];
        if (nloc == 0u) { xcd_barrier_complete(bar, b.x, nloc, nx); b.st[0] = nloc; b.st[1] = nx; }
        const unsigned old = xb_add(&bar[XB_XSUB(b.x)], 1u);
        const unsigned gen = old / nloc;
        if (old + 1u == (gen + 1u) * nloc) {
            __builtin_amdgcn_fence(__ATOMIC_RELEASE, "agent");
            asm volatile("s_waitcnt vmcnt(0)" ::: "memory");
            const unsigned og = xb_add(&bar[XB_TOP], 1u);
            const unsigned tg = og / nx;
            if (og + 1u == (tg + 1u) * nx) {
                xb_add(&bar[XB_TOPGEN], 1u); xb_add(&bar[XB_XGEN(b.x)], 1u);
                __builtin_amdgcn_fence(__ATOMIC_ACQUIRE, "agent");
            } else {
                __builtin_amdgcn_fence(__ATOMIC_ACQUIRE, "agent");
                XB_SPIN(xb_ld(&bar[XB_TOPGEN]) == tg, bar);
                xb_add(&bar[XB_XGEN(b.x)], 1u);
            }
            asm volatile("s_waitcnt vmcnt(0)" ::: "memory");
        } else {
            __builtin_amdgcn_fence(__ATOMIC_ACQUIRE, "agent");
            XB_SPIN(xb_ld(&bar[XB_XGEN(b.x)]) == gen, bar);
            asm volatile("s_waitcnt vmcnt(0)" ::: "memory");
        }
    }
    __syncthreads();
}
struct Args { const float* in[19]; float* out; unsigned char* ws; int ph_lo, ph_hi, li, pad; };
struct Frame {
    LAS unsigned char* lds; int tid, lane, wave, G, bx;
};
__device__ __forceinline__ float wave_sum(float v) {
#pragma unroll
    for (int o = 1; o < 64; o <<= 1) v += __shfl_xor(v, o);
    return v;
}
__device__ __forceinline__ int slot5(int i) { return 16 * ((i >> 2) & 1) + 4 * (i >> 3) + (i & 3); }
__device__ __forceinline__ int dest_row(int mode, int c) {
    if (mode == 1) { const int hs = c >= FF ? 1 : 0, j = c - FF * hs; return 256 * (j >> 7) + 128 * hs + (j & 96) + slot5(j & 31); }
    if (mode == 2) { if (c < 1536) return c; if (c < 2048) return (c & ~31) + slot5(c & 31);     const int cc = c - 2048, hs = cc >> 9, j = cc & 511; return 2048 + 256 * (j >> 7) + 128 * hs + (j & 96) + slot5(j & 31); }
    if (mode == 3) return (c & ~31) + slot5(c & 31);
    return c;
}
__device__ __forceinline__ void tr_item(const float* W, int ldw, bf16* WT, size_t ldt, int k0, int n0, int mode, LAS float* scr, int lane) {
#pragma unroll 8
    for (int i = 0; i < 32; ++i) { const int kk = 2 * i + (lane >> 5); scr[kk * 33 + (lane & 31)] = __builtin_nontemporal_load(W + (size_t)(k0 + kk) * ldw + n0 + (lane & 31)); }
    LDS_WAIT(); asm volatile("" ::: "memory");
    const int c = lane & 7;
#pragma unroll
    for (int j = 0; j < 4; ++j) { const int n = (lane >> 3) + 8 * j; const LAS float* s = scr + (8 * c) * 33 + n;
        v4u o; o.x = pk2(s[0 * 33], s[1 * 33]); o.y = pk2(s[2 * 33], s[3 * 33]); o.z = pk2(s[4 * 33], s[5 * 33]); o.w = pk2(s[6 * 33], s[7 * 33]);
        *(v4u*)(WT + (size_t)dest_row(mode, n0 + n) * ldt + k0 + 8 * c) = o; }
    LDS_WAIT(); asm volatile("" ::: "memory");
}
__device__ __forceinline__ void p0_prologue(const Frame& F, const Args& a) {
    unsigned char* ws = a.ws;
    float* mod = (float*)(ws + WS_MISC);
    if (F.bx < NMODC / 64) {
        LAS float* sl = (LAS float*)F.lds;
        for (int i = F.tid; i < 3 * D; i += NWAVES * 64) { const int r = i >> 10, k = i & 1023; const float c = (r == 0) ? a.in[5][k] : a.in[2][(r - 1) * D + k]; sl[i] = c / (1.0f + __expf(-c)); }
        __syncthreads();
        for (int it = F.bx; it < NMODC / 64; it += F.G) {
            const float* w = a.in[6] + (size_t)(128 * F.wave) * NMODC + it * 64 + F.lane;
            float a0 = 0.f, a1 = 0.f, a2 = 0.f;
#pragma unroll 16
            for (int k = 0; k < 128; ++k) { const float wv = __builtin_nontemporal_load(w + (size_t)k * NMODC); const int kk = 128 * F.wave + k; a0 += sl[kk] * wv; a1 += sl[D + kk] * wv; a2 += sl[2 * D + kk] * wv; }
            LAS float* red = (LAS float*)(F.lds + 16384);
            red[(F.wave * 3 + 0) * 64 + F.lane] = a0; red[(F.wave * 3 + 1) * 64 + F.lane] = a1; red[(F.wave * 3 + 2) * 64 + F.lane] = a2;
            __syncthreads();
            if (F.tid < 192) { const int r = F.tid >> 6, l = F.tid & 63; float s = a.in[7][it * 64 + l];
#pragma unroll
                for (int w8 = 0; w8 < 8; ++w8) s += red[(w8 * 3 + r) * 64 + l];
                mod[r * NMODC + it * 64 + l] = s; }
            __syncthreads();
        }
    }
    if (F.bx == F.G - 1) {
        float* rc = (float*)(ws + WS_MISC + 128 * 1024); float* rs = rc + 1024;
        for (int i = F.tid; i < 1024; i += NWAVES * 64) { const int pos = i >> 4, f = i & 15; const float fr = powf(10000.0f, -(float)(2 * f) / 32.0f); float sn, cs; sincosf((float)pos * fr, &sn, &cs); rc[i] = cs; rs[i] = sn; }
    }
    __syncthreads();
    LAS float* scr = (LAS float*)(F.lds + F.wave * 16384);
    const int gw = F.bx * NWAVES + F.wave, NGW = F.G * NWAVES;
    constexpr int I_UP = (D / 64) * (NUP / 32);
    const int h0 = (F.G >= 2 * (NMODC / 64) - 32) ? NMODC / 64 : 0;
    if (F.bx >= h0) for (int r = (F.bx - h0) * NWAVES + F.wave; r < I_UP; r += (F.G - h0) * NWAVES) tr_item(a.in[10], NUP, (bf16*)(ws + WS_W1U), D, 64 * (r / (NUP / 32)), 32 * (r % (NUP / 32)), 1, scr, F.lane);
}
__device__ __forceinline__ void deferred_items(const Frame& F, const Args& a, int set, int hw, int NHW) {
    unsigned char* ws = a.ws;
    LAS float* scr = (LAS float*)(F.lds + F.wave * 16384);
    constexpr int I_UP = (D / 64) * (NUP / 32), I_DN = (FF / 64) * (D / 32), I_IN = (D / 64) * (NIN / 32), I_O = (D / 64) * (D / 32), I_CV = (PAST / 64) * (AW / 32);
    if (set == 0) { for (int r = hw; r < I_DN; r += NHW) tr_item(a.in[11], D, (bf16*)(ws + WS_W1D), FF, 64 * (r / (D / 32)), 32 * (r % (D / 32)), 3, scr, F.lane); return; }
    constexpr int NITEMS = I_UP + I_DN + I_IN + I_O + 2 * I_CV;
    for (int it = hw; it < NITEMS; it += NHW) {
        int r = it;
        if (r < I_UP) { tr_item(a.in[12], NUP, (bf16*)(ws + WS_W2U), D, 64 * (r / (NUP / 32)), 32 * (r % (NUP / 32)), 1, scr, F.lane); continue; } r -= I_UP;
        if (r < I_DN) { tr_item(a.in[13], D, (bf16*)(ws + WS_W2D), FF, 64 * (r / (D / 32)), 32 * (r % (D / 32)), 3, scr, F.lane); continue; } r -= I_DN;
        if (r < I_IN) { tr_item(a.in[14], NIN, (bf16*)(ws + WS_WIN), D, 64 * (r / (NIN / 32)), 32 * (r % (NIN / 32)), 2, scr, F.lane); continue; } r -= I_IN;
        if (r < I_O) { tr_item(a.in[18], D, (bf16*)(ws + WS_WO), D, 64 * (r / (D / 32)), 32 * (r % (D / 32)), 3, scr, F.lane); continue; } r -= I_O;
        { const int b = r / I_CV; r -= b * I_CV;
          tr_item(a.in[4] + (size_t)b * PAST * AW, AW, (bf16*)(ws + WS_VTLAT) + (size_t)b * AW * TKL, TKL, 64 * (r / (AW / 32)), 32 * (r % (AW / 32)), 0, scr, F.lane); }
    }
    for (int i = hw * 64 + F.lane; i < 2 * PAST * AW / 4; i += NHW * 64) {
        const int e = i * 4, b = e / (PAST * AW), rem = e - b * (PAST * AW);
        const f32x4 v = __builtin_nontemporal_load((const f32x4*)(a.in[3] + e)); v2u o; o.x = pk2(v[0], v[1]); o.y = pk2(v[2], v[3]);
        const int d = rem & 31, remp = (rem & ~31) + 8 * ((d >> 2) & 3) + 4 * (d >> 4);
        *(v2u*)((bf16*)(ws + WS_KLAT) + (size_t)b * TKL * AW + remp) = o; }
}
__device__ __forceinline__ const float* xrow_in(const Args& a, int m) { return m < MC ? a.in[0] + (size_t)m * D : a.in[1] + (size_t)(m - MC) * D; }
__device__ __forceinline__ int modrow(int m) { return m < MC ? 0 : 1 + ((m - MC) >> 10); }
__device__ __forceinline__ void norm_mod_store(const f32x4 (&x)[4], const float* g, const float* sh, const float* sc, bf16* urow, int lane) {
    float ss = 0.f;
#pragma unroll
    for (int j = 0; j < 4; ++j) ss += (x[j][0] * x[j][0] + x[j][1] * x[j][1]) + (x[j][2] * x[j][2] + x[j][3] * x[j][3]);
    const float rstd = 1.0f / sqrtf(wave_sum(ss) * (1.0f / D) + EPS);
#pragma unroll
    for (int j = 0; j < 4; ++j) { const int c = 4 * (lane + 64 * j); const f32x4 gv = *(const f32x4*)(g + c), sv = *(const f32x4*)(sh + c), cv = *(const f32x4*)(sc + c);
        const f32x4 u = x[j] * rstd * gv * (cv + 1.0f) + sv; v2u o; o.x = pk2(u[0], u[1]); o.y = pk2(u[2], u[3]); *(v2u*)(urow + c) = o; }
}
__device__ __forceinline__ void row_phase(const Frame& F, const Args& a, int sub) {
    unsigned char* ws = a.ws; const float* mod = (const float*)(ws + WS_MISC);
    const bf16* Y = (const bf16*)(ws + WS_Y); bf16* X1 = (bf16*)(ws + WS_X1); bf16* U = (bf16*)(ws + WS_U);
    const int gw = F.bx * NWAVES + F.wave, NGW = F.G * NWAVES, lane = F.lane;
    int rcur = -1; f32x4 A[4], B[4], C[4];
    for (int m = gw; m < M; m += NGW) {
        const int r = modrow(m);
        if (r != rcur) { rcur = r; const float* mr = mod + r * NMODC;
#pragma unroll
            for (int j = 0; j < 4; ++j) { const int c = 4 * (lane + 64 * j);
                if (sub >= 1) { const int i = sub - 1; const float gs = (i == 1) ? 1.0f : 0.5f; A[j] = (*(const f32x4*)(mr + (i * 3 + 2) * D + c) * gs) * *(const f32x4*)(a.in[9] + i * D + c); }
                if (sub <= 2) { B[j] = *(const f32x4*)(a.in[8] + sub * D + c) * (*(const f32x4*)(mr + (sub * 3 + 1) * D + c) + 1.0f); C[j] = *(const f32x4*)(mr + (sub * 3 + 0) * D + c); } } }
        f32x4 x[4];
        if (sub <= 1) { const float* xp = xrow_in(a, m);
#pragma unroll
            for (int j = 0; j < 4; ++j) x[j] = (sub == 1) ? __builtin_nontemporal_load((const f32x4*)(xp + 4 * (lane + 64 * j))) : *(const f32x4*)(xp + 4 * (lane + 64 * j));
        } else {
#pragma unroll
            for (int j = 0; j < 4; ++j) { const v2u xw = __builtin_nontemporal_load((const v2u*)(X1 + (size_t)m * D + 4 * (lane + 64 * j))); x[j] = (f32x4){__uint_as_float(xw.x << 16), __uint_as_float(xw.x & 0xffff0000u), __uint_as_float(xw.y << 16), __uint_as_float(xw.y & 0xffff0000u)}; }
        }
        if (sub >= 1) {
            f32x4 y[4]; float ss = 0.f;
#pragma unroll
            for (int j = 0; j < 4; ++j) { const v2u yw = __builtin_nontemporal_load((const v2u*)(Y + (size_t)m * D + 4 * (lane + 64 * j))); y[j] = (f32x4){__uint_as_float(yw.x << 16), __uint_as_float(yw.x & 0xffff0000u), __uint_as_float(yw.y << 16), __uint_as_float(yw.y & 0xffff0000u)}; ss += (y[j][0] * y[j][0] + y[j][1] * y[j][1]) + (y[j][2] * y[j][2] + y[j][3] * y[j][3]); }
            const float rstd = 1.0f / sqrtf(wave_sum(ss) * (1.0f / D) + EPS);
#pragma unroll
            for (int j = 0; j < 4; ++j) { const int c = 4 * (lane + 64 * j);
                x[j] = x[j] + A[j] * (y[j] * rstd);
                if (sub == 3) *(f32x4*)(a.out + OUT_Y + (size_t)m * D + c) = x[j];
                else { v2u o; o.x = pk2(x[j][0], x[j][1]); o.y = pk2(x[j][2], x[j][3]); *(v2u*)(X1 + (size_t)m * D + c) = o; } }
        }
        if (sub <= 2) {
            float ss = 0.f;
#pragma unroll
            for (int j = 0; j < 4; ++j) ss += (x[j][0] * x[j][0] + x[j][1] * x[j][1]) + (x[j][2] * x[j][2] + x[j][3] * x[j][3]);
            const float rstd = 1.0f / sqrtf(wave_sum(ss) * (1.0f / D) + EPS);
#pragma unroll
            for (int j = 0; j < 4; ++j) { const int c = 4 * (lane + 64 * j); const f32x4 u = (x[j] * rstd) * B[j] + C[j]; v2u o; o.x = pk2(u[0], u[1]); o.y = pk2(u[2], u[3]); *(v2u*)(U + (size_t)m * D + c) = o; }
        }
    }
}
__device__ __forceinline__ float max3f(float a, float b, float c) { float r; asm("v_max3_f32 %0, %1, %2, %3" : "=v"(r) : "v"(a), "v"(b), "v"(c)); return r; }
constexpr int AT_STG = 32768;
static_assert(4 * AT_STG <= RING_BYTES && 4 * 16896 <= RING_BYTES, "attention LDS");
#define AT_WAIT_V(n) asm volatile("s_waitcnt vmcnt(" #n ")" ::: "memory")
template <bool LAT, int VAR = 0>
__device__ __forceinline__ void attn_unit(const Frame& F, const bf16* Qb, const bf16* Kp, const bf16* Vt, int ldv, int T, int qrow0, int h, float lam, const float* subg, bf16* MIX) {
    const int tid = F.tid, lane = F.lane, wid = F.wave, r = lane & 31, hh = lane >> 5, map = wid & 1;
    const int kvh = LAT ? ((wid >> 1) & 1) : 0, qb = LAT ? (wid >> 2) : (wid >> 1);
    const int qrow = qrow0 + 32 * qb + r;
    const bf16* qp = Qb + (size_t)qrow * AW + h * 128 + map * 64 + 8 * hh;
    bf16x8 qf[4];
#pragma unroll
    for (int kk = 0; kk < 4; ++kk) qf[kk] = *(const bf16x8*)(qp + 16 * kk);
    asm volatile("" : "+v"(qf[0]), "+v"(qf[1]), "+v"(qf[2]), "+v"(qf[3]));
    unsigned kgo[2], vgo[2];
#pragma unroll
    for (int i = 0; i < 2; ++i) { const int q = i * 512 + tid;
        { const int key = q >> 4, part = (q & 15) ^ (key & 15); kgo[i] = (unsigned)(key * AW + h * 128 + part * 8); }
        { const int e = q >> 3, part = (q & 7) ^ ((e >> 1) & 7); vgo[i] = (unsigned)((h * 128 + e) * ldv + part * 8); } }
    const unsigned ldsw = (unsigned)wid * 1024u;
#define AT_GLDS_K(s, slot, i_) __builtin_amdgcn_global_load_lds((const unsigned*)(Kp + (size_t)(s) * 64 * AW + kgo[i_]), (LAS unsigned*)(F.lds + (slot) * AT_STG + (i_) * 8192 + ldsw), 16, 0, 0)
#define AT_GLDS_V(s, slot, i_) __builtin_amdgcn_global_load_lds((const unsigned*)(Vt + (s) * 64 + vgo[i_]), (LAS unsigned*)(F.lds + (slot) * AT_STG + 16384 + (i_) * 8192 + ldsw), 16, 0, 0)
#define AT_STAGE(s, slot) do { AT_GLDS_K(s, slot, 0); AT_GLDS_V(s, slot, 0); AT_GLDS_K(s, slot, 1); AT_GLDS_V(s, slot, 1); } while (0)
#define AT_PIN() __builtin_amdgcn_sched_barrier(0)
    const int rp = (r & 19) | ((r & 4) << 1) | ((r & 8) >> 1);
    int kread[4], vread[2];
#pragma unroll
    for (int kk = 0; kk < 4; ++kk) kread[kk] = rp * 256 + (((map * 8 + 2 * kk + hh) ^ (rp & 15)) * 16);
#pragma unroll
    for (int s2 = 0; s2 < 2; ++s2) vread[s2] = 16384 + r * 128 + (((2 * s2 + hh) ^ ((r >> 1) & 7)) * 16);
    f32x16 acc[4];
#pragma unroll
    for (int et = 0; et < 4; ++et)
#pragma unroll
        for (int i = 0; i < 16; ++i) acc[et][i] = 0.f;
    float mrun = -INFINITY, lrun = 0.f;
    __builtin_amdgcn_s_barrier();
    __builtin_amdgcn_sched_barrier(0);
    if (VAR != 1) { AT_STAGE(0, 0); AT_STAGE((T > 1 ? 1 : T - 1), 1); AT_STAGE((T > 2 ? 2 : T - 1), 2); }
    for (int t = 0; t < T; ++t) {
        if (VAR != 1) AT_WAIT_V(8);
        __builtin_amdgcn_s_barrier();
        __builtin_amdgcn_sched_barrier(0);
        const int sn = (t + 3 < T) ? t + 3 : T - 1, sl = (t + 3) & 3;
        const LAS unsigned char* buf = F.lds + (t & 3) * AT_STG;
        if (VAR == 2) AT_STAGE(sn, sl);
#pragma unroll
        for (int jj = 0; jj < (VAR == 2 ? 0 : (LAT ? 1 : 2)); ++jj) {
            const int j = LAT ? kvh : jj;
            bf16x8 kf[4];
#pragma unroll
            for (int kk = 0; kk < 4; ++kk) kf[kk] = *(const LAS bf16x8*)(buf + kread[kk] + j * 32 * 256);
            f32x16 s;
#pragma unroll
            for (int i = 0; i < 16; ++i) s[i] = 0.f;
#pragma unroll
            for (int kk = 0; kk < 4; ++kk) s = __builtin_amdgcn_mfma_f32_32x32x16_bf16(kf[kk], qf[kk], s, 0, 0, 0);
            if (VAR != 1) { AT_PIN(); if (LAT) { AT_GLDS_K(sn, sl, 0); AT_GLDS_V(sn, sl, 0); } else if (jj == 0) AT_GLDS_K(sn, sl, 0); else AT_GLDS_K(sn, sl, 1); AT_PIN(); }
            bf16x8 vf[4][2];
#pragma unroll
            for (int et = 0; et < 4; ++et)
#pragma unroll
                for (int s2 = 0; s2 < 2; ++s2) vf[et][s2] = *(const LAS bf16x8*)(buf + (vread[s2] ^ (j * 64)) + et * 32 * 128);
            float mx = fmaxf(fmaxf(fmaxf(s[0], s[1]), fmaxf(s[2], s[3])), fmaxf(fmaxf(s[4], s[5]), fmaxf(s[6], s[7])));
            mx = fmaxf(mx, fmaxf(fmaxf(fmaxf(s[8], s[9]), fmaxf(s[10], s[11])), fmaxf(fmaxf(s[12], s[13]), fmaxf(s[14], s[15]))));
            mx = fmaxf(mx, mrun);
            const float mnew = fmaxf(mx, __shfl_xor(mx, 32));
            if (__builtin_amdgcn_ballot_w64(mnew > mrun + 8.0f) != 0ull) {
                const float alpha = __builtin_amdgcn_exp2f(mrun - mnew);
                lrun *= alpha;
#pragma unroll
                for (int et = 0; et < 4; ++et) acc[et] = acc[et] * alpha;
                mrun = mnew; }
            float ps = 0.f;
#pragma unroll
            for (int i = 0; i < 16; ++i) { s[i] = __builtin_amdgcn_exp2f(s[i] - mrun); ps += s[i]; }
            lrun += ps;
            bf16x8 pf[2];
#pragma unroll
            for (int s2 = 0; s2 < 2; ++s2) { v4u w; w.x = pk2(s[8 * s2 + 0], s[8 * s2 + 1]); w.y = pk2(s[8 * s2 + 2], s[8 * s2 + 3]); w.z = pk2(s[8 * s2 + 4], s[8 * s2 + 5]); w.w = pk2(s[8 * s2 + 6], s[8 * s2 + 7]); pf[s2] = __builtin_bit_cast(bf16x8, w); }
            if (VAR != 1) { AT_PIN(); if (LAT) { AT_GLDS_K(sn, sl, 1); AT_GLDS_V(sn, sl, 1); } else if (jj == 0) AT_GLDS_V(sn, sl, 0); else AT_GLDS_V(sn, sl, 1); AT_PIN(); }
#pragma unroll
            for (int et = 0; et < 4; ++et)
#pragma unroll
                for (int s2 = 0; s2 < 2; ++s2) acc[et] = __builtin_amdgcn_mfma_f32_32x32x16_bf16(vf[et][s2], pf[s2], acc[et], 0, 0, 0);
        }
    }
    AT_WAIT_V(0);
    __syncthreads();
    if (LAT) {
        LAS float* mb = (LAS float*)(F.lds + (qb * 2 + map) * 16896);
        if (kvh) {
#pragma unroll
            for (int et = 0; et < 4; ++et)
#pragma unroll
                for (int i = 0; i < 16; ++i) mb[(et * 16 + i) * 64 + lane] = acc[et][i];
            mb[4096 + lane] = mrun; mb[4160 + lane] = lrun; }
        __syncthreads();
        if (!kvh) { const float m1 = mb[4096 + lane], l1 = mb[4160 + lane], mt = fmaxf(mrun, m1), a0 = __builtin_amdgcn_exp2f(mrun - mt), a1 = __builtin_amdgcn_exp2f(m1 - mt);
            lrun = lrun * a0 + l1 * a1;
#pragma unroll
            for (int et = 0; et < 4; ++et)
#pragma unroll
                for (int i = 0; i < 16; ++i) acc[et][i] = acc[et][i] * a0 + mb[(et * 16 + i) * 64 + lane] * a1; }
        __syncthreads();
    }
    const float ltot = lrun + __shfl_xor(lrun, 32);
    const float inv = (map ? lam : 1.0f) / ltot;
    LAS float* xb = (LAS float*)(F.lds + qb * 16384);
    if (map && !kvh) {
#pragma unroll
        for (int et = 0; et < 4; ++et)
#pragma unroll
            for (int i = 0; i < 16; ++i) xb[(et * 16 + i) * 64 + lane] = acc[et][i] * inv;
    }
    __syncthreads();
    if (!map && !kvh) {
        f32x4 gv[4][4];
#pragma unroll
        for (int et = 0; et < 4; ++et)
#pragma unroll
            for (int g = 0; g < 4; ++g) gv[et][g] = *(const f32x4*)(subg + 32 * et + 8 * g + 4 * hh);
        float ss = 0.f;
#pragma unroll
        for (int et = 0; et < 4; ++et)
#pragma unroll
            for (int i = 0; i < 16; ++i) { const float o = acc[et][i] * inv - xb[(et * 16 + i) * 64 + lane]; acc[et][i] = o; ss += o * o; }
        ss += __shfl_xor(ss, 32);
        const float rstd = 0.8f / sqrtf(ss * (1.0f / 128.0f) + EPS);
        bf16* op = MIX + (size_t)qrow * D + h * 128 + 4 * hh;
#pragma unroll
        for (int et = 0; et < 4; ++et)
#pragma unroll
            for (int g = 0; g < 4; ++g) { const int e = 32 * et + 8 * g;
                v2u w; w.x = pk2(acc[et][4 * g + 0] * rstd * gv[et][g][0], acc[et][4 * g + 1] * rstd * gv[et][g][1]); w.y = pk2(acc[et][4 * g + 2] * rstd * gv[et][g][2], acc[et][4 * g + 3] * rstd * gv[et][g][3]);
                *(v2u*)(op + e) = w; }
    }
    asm volatile("s_waitcnt vmcnt(0)" ::: "memory");
#undef AT_STAGE
#undef AT_GLDS_K
#undef AT_GLDS_V
#undef AT_PIN
}
__device__ __forceinline__ void attn_conv_phase(const Frame& F, const Args& a, int parts) {
    unsigned char* ws = a.ws;
    const bf16* Qb = (const bf16*)(ws + WS_QB); const bf16* Kctx = (const bf16*)(ws + WS_KCTX); const bf16* Klat = (const bf16*)(ws + WS_KLAT);
    const bf16* Vtctx = (const bf16*)(ws + WS_VTCTX); const bf16* Vtlat = (const bf16*)(ws + WS_VTLAT); bf16* MIX = (bf16*)(ws + WS_MIX);
    const float* lq = a.in[16];
    const float d01 = wave_sum(lq[F.lane] * lq[64 + F.lane]), d23 = wave_sum(lq[128 + F.lane] * lq[192 + F.lane]);
    const float lam = expf(d01) - expf(d23) + 0.2f;
    const int NU = 128 + 256;
    int u = F.bx, ustep = F.G;
    if (F.G == 256 && F.bx >= 128) ustep = 128;
    for (; u < NU; u += ustep) {
        if (F.G == 256 && F.bx < 128 && u >= 128) break;
        if (u < 128 ? !(parts & 1) : !(parts & 2)) continue;
        if (u < 128) { const int bh = u & 7, b = bh >> 2, h = bh & 3, qk = u >> 3;
            if (parts & 8) attn_unit<true, 1>(F, Qb, Klat + (size_t)b * TKL * AW, Vtlat + (size_t)b * AW * TKL, TKL, TKL / 64, MC + b * TL + qk * 64, h, lam, a.in[17], (bf16*)(ws + 216 * MiB));
            else if (parts & 16) attn_unit<true, 2>(F, Qb, Klat + (size_t)b * TKL * AW, Vtlat + (size_t)b * AW * TKL, TKL, TKL / 64, MC + b * TL + qk * 64, h, lam, a.in[17], (bf16*)(ws + 216 * MiB));
            else attn_unit<true>(F, Qb, Klat + (size_t)b * TKL * AW, Vtlat + (size_t)b * AW * TKL, TKL, TKL / 64, MC + b * TL + qk * 64, h, lam, a.in[17], MIX);
        } else { const int uc = u - 128, bh = uc >> 1, b = bh >> 2, h = bh & 3, qk = uc & 1;
            attn_unit<false>(F, Qb, Kctx + (size_t)b * TC * AW, Vtctx + (size_t)b * AW * TC, TC, TC / 64, b * TC + qk * 128, h, lam, a.in[17], MIX); }
    }
    __syncthreads();
    {
        const bf16* BGb = (const bf16*)(ws + WS_BG); const bf16* Zb = (const bf16*)(ws + WS_Z); const float* cw = a.in[15];
        const int t0 = F.bx * NWAVES * 64 + F.tid, tstep = F.G * NWAVES * 64, c = (F.tid & 63) * 8;
        float w0[8], w1[8], w2[8];
#pragma unroll
        for (int j = 0; j < 8; ++j) { w0[j] = cw[c + j]; w1[j] = cw[AW + c + j]; w2[j] = cw[2 * AW + c + j]; }
        constexpr int CB = 5;
        for (int i0 = (parts & 4) ? t0 : M * 64; i0 < M * 64; i0 += CB * tstep) {
            v4u zc[CB], bgv[CB], zp[CB], zn[CB];
#pragma unroll
            for (int k = 0; k < CB; ++k) { const int i = i0 + k * tstep, m = (i < M * 64) ? (i >> 6) : 0;
                const int tl = m < MC ? (m & 255) : ((m - MC) & 1023), T = m < MC ? TC : TL;
                zc[k] = *(const v4u*)(Zb + (size_t)m * AW + c); bgv[k] = *(const v4u*)(BGb + (size_t)m * AW + c);
                zp[k] = *(const v4u*)(Zb + (size_t)(tl > 0 ? m - 1 : m) * AW + c); zn[k] = *(const v4u*)(Zb + (size_t)(tl < T - 1 ? m + 1 : m) * AW + c);
                if (tl == 0) zp[k] = (v4u){0u, 0u, 0u, 0u};
                if (tl == T - 1) zn[k] = (v4u){0u, 0u, 0u, 0u}; }
#pragma unroll
            for (int k = 0; k < CB; ++k) { const int i = i0 + k * tstep; if (i >= M * 64) break; const int m = i >> 6;
                float o[8];
#pragma unroll
                for (int j = 0; j < 8; ++j) {
                    const unsigned sh = (j & 1) * 16;
                    const float fp = __uint_as_float(((zp[k][j >> 1] >> sh) & 0xffffu) << 16), fc = __uint_as_float(((zc[k][j >> 1] >> sh) & 0xffffu) << 16), fn = __uint_as_float(((zn[k][j >> 1] >> sh) & 0xffffu) << 16);
                    const float fb = __uint_as_float(((bgv[k][j >> 1] >> sh) & 0xffffu) << 16);
                    o[j] = fb * (w0[j] * fp + w1[j] * fc + w2[j] * fn); }
                v4u w; w.x = pk2(o[0], o[1]); w.y = pk2(o[2], o[3]); w.z = pk2(o[4], o[5]); w.w = pk2(o[6], o[7]);
                *(v4u*)(MIX + (size_t)m * D + AW + c) = w; }
        }
    }
}
constexpr int NPH = 12;
__global__ void __launch_bounds__(NWAVES * 64, 2) fwd_mk(Args args) {
    extern __shared__ __attribute__((aligned(16))) unsigned char lds[];
    Frame F; F.lds = (LAS unsigned char*)lds; F.tid = threadIdx.x; F.lane = F.tid & 63; F.wave = __builtin_amdgcn_readfirstlane(F.tid >> 6); F.G = gridDim.x; F.bx = blockIdx.x;
    unsigned char* ws = args.ws;
    for (int u = F.tid; u < (LDS_BYTES - LDSCTL_OFF) / 4; u += NWAVES * 64) ((LAS unsigned*)(F.lds + LDSCTL_OFF))[u] = 0u;
    __syncthreads();
    XcdBarrier bar; bar.bar = (unsigned*)(ws + WS_CTL) + CW_BAR; bar.x = 0; bar.st = nullptr;
    if (MK_N_LAUNCHES == 1) bar = xcd_barrier_post((unsigned*)(ws + WS_CTL) + CW_BAR, (volatile LAS unsigned*)(F.lds + MISC_OFF) + 8);
    const int lo = args.ph_lo, hi = args.ph_hi;
#define IN(k) (lo <= (k) && (k) < hi)
#define SEAM(k) do { if (IN(k) && IN((k) + 1)) xcd_barrier(bar); } while (0)
#ifndef PROBE_PARTS
#define PROBE_PARTS 7
#endif
#ifndef PROBE_DUP
#define PROBE_DUP -1
#endif
#define REP(k) for (int rep_ = 0; rep_ < ((k) == PROBE_DUP ? 2 : 1); ++rep_, ((k) == PROBE_DUP && rep_ == 1 ? xcd_barrier(bar) : (void)0))
    bf16* U = (bf16*)(ws + WS_U); bf16* Gb = (bf16*)(ws + WS_G); bf16* Y = (bf16*)(ws + WS_Y);
    if (IN(0)) REP(0) { p0_prologue(F, args); } SEAM(0);
    if (IN(1)) REP(1) { row_phase(F, args, 0); } SEAM(1);
    if (IN(2)) REP(2) { pg8::Gemm g{U, (const bf16*)(ws + WS_W1U), M, NUP, D}; pg8::StaticOrder S; S.init(M, NUP, F.G, F.bx); pg8::EpiSwiGLU E{Gb, FF};
        pg8::gemm_phase<pg8::EpiSwiGLU, pg8::StaticOrder, true, true>(F.lds, g, S, E);
        { const int nwg = (M / 256) * (NUP / 256), c0 = nwg % F.G, h0 = (nwg > F.G) ? c0 : 0;
          if (F.bx >= h0) deferred_items(F, args, 0, (F.bx - h0) * NWAVES + F.wave, (F.G - h0) * NWAVES); } } SEAM(2);
    if (IN(3)) REP(3) { pg8::Gemm g{Gb, (const bf16*)(ws + WS_W1D), M, D, FF}; pg8::StaticOrder S; S.init(M, D, F.G, F.bx); pg8::EpiY E{Y, D};
        pg8::gemm_phase<pg8::EpiY, pg8::StaticOrder, true, true>(F.lds, g, S, E);
        { const int nwg = (M / 256) * (D / 256), h0 = F.G > nwg ? nwg : 0;
          if (F.bx >= h0) deferred_items(F, args, 1, (F.bx - h0) * NWAVES + F.wave, (F.G - h0) * NWAVES); } } SEAM(3);
    if (IN(4)) REP(4) { row_phase(F, args, 1); } SEAM(4);
    if (IN(5)) REP(5) { pg8::Gemm g{U, (const bf16*)(ws + WS_WIN), M, NIN, D}; pg8::StaticOrder S; S.init(M, NIN, F.G, F.bx);
        pg8::EpiMix E{(bf16*)(ws + WS_QB), (bf16*)(ws + WS_KCTX), (bf16*)(ws + WS_KLAT), (bf16*)(ws + WS_VTCTX), (bf16*)(ws + WS_VTLAT), (bf16*)(ws + WS_BG), (bf16*)(ws + WS_Z),
                      args.out + OUT_NK, args.out + OUT_NV, (const float*)(ws + WS_MISC + 128 * 1024), (const float*)(ws + WS_MISC + 128 * 1024) + 1024};
        pg8::gemm_phase<pg8::EpiMix, pg8::StaticOrder, true, true>(F.lds, g, S, E); } SEAM(5);
    if (IN(6)) REP(6) { attn_conv_phase(F, args, 7); } SEAM(6);
    if (IN(7)) REP(7) { pg8::Gemm g{(const bf16*)(ws + WS_MIX), (const bf16*)(ws + WS_WO), M, D, D}; pg8::StaticOrder S; S.init(M, D, F.G, F.bx); pg8::EpiY E{Y, D};
        pg8::gemm_phase<pg8::EpiY, pg8::StaticOrder, true, true>(F.lds, g, S, E); } SEAM(7);
    if (IN(8)) REP(8) { row_phase(F, args, 2); } SEAM(8);
    if (IN(9)) REP(9) { pg8::Gemm g{U, (const bf16*)(ws + WS_W2U), M, NUP, D}; pg8::StaticOrder S; S.init(M, NUP, F.G, F.bx); pg8::EpiSwiGLU E{Gb, FF};
        pg8::gemm_phase<pg8::EpiSwiGLU, pg8::StaticOrder, true, true>(F.lds, g, S, E); } SEAM(9);
    if (IN(10)) REP(10) { pg8::Gemm g{Gb, (const bf16*)(ws + WS_W2D), M, D, FF}; pg8::StaticOrder S; S.init(M, D, F.G, F.bx); pg8::EpiY E{Y, D};
        pg8::gemm_phase<pg8::EpiY, pg8::StaticOrder, true, true>(F.lds, g, S, E); } SEAM(10);
    if (IN(11)) REP(11) { row_phase(F, args, 3); }
#undef IN
#undef SEAM
}

extern "C" void kernel_launch(void* const* d_in, const int* in_sizes, int n_in, void* d_out, int out_size, void* d_ws, size_t ws_size, hipStream_t stream) {
    static int grid = 0;
    if (grid == 0) {
        if (n_in != 19 || ws_size < WS_END) { fprintf(stderr, "kernel_launch: unexpected n_in %d / ws %zu\n", n_in, ws_size); grid = -1; return; }
        int dev = 0, cus = 0, per_cu = 0;
        if (hipGetDevice(&dev) != hipSuccess || hipDeviceGetAttribute(&cus, hipDeviceAttributeMultiprocessorCount, dev) != hipSuccess) { grid = -1; return; }
        if (hipFuncSetAttribute((const void*)fwd_mk, hipFuncAttributeMaxDynamicSharedMemorySize, LDS_BYTES) != hipSuccess) { fprintf(stderr, "kernel_launch: hipFuncSetAttribute failed\n"); grid = -1; return; }
        if (hipOccupancyMaxActiveBlocksPerMultiprocessor(&per_cu, (const void*)fwd_mk, NWAVES * 64, LDS_BYTES) != hipSuccess || per_cu < 1) fprintf(stderr, "kernel_launch: occupancy query says %d\n", per_cu);
        (void)hipGetLastError();
        grid = cus;
    }
    if (grid < 0) return;
    (void)hipMemsetAsync((char*)d_ws + WS_CTL, 0, CTL_ZERO_BYTES, stream);
    Args a{};
    for (int i = 0; i < 19; ++i) a.in[i] = (const float*)d_in[i];
    a.out = (float*)d_out; a.ws = (unsigned char*)d_ws;
#if MK_N_LAUNCHES == 1
    a.ph_lo = 0; a.ph_hi = NPH; a.li = 0;
    void* kargs[] = {&a};
    hipError_t e = hipLaunchCooperativeKernel((const void*)fwd_mk, dim3(grid), dim3(NWAVES * 64), kargs, LDS_BYTES, stream);
    if (e != hipSuccess) fprintf(stderr, "kernel_launch: cooperative launch failed: %s (grid %d)\n", hipGetErrorString(e), grid);
#else
    for (int li = 0; li < NPH; ++li) { a.ph_lo = li; a.ph_hi = li + 1; a.li = li; hipLaunchKernelGGL(fwd_mk, dim3(grid), dim3(NWAVES * 64), LDS_BYTES, stream, a); }
#endif
}
```
